# Optimizing an MI355X kernel written in HIP

```python
import jax, jax.numpy as jnp
from jax import lax
import numpy as np

D_MODEL = 2048
BATCH = 2
SEQ = 8192
DEPTH = 2
DEC_BATCH = 1
DEC_SEQ = 16384
PAST_LEN = 128

N_MEM = 256
D_MIX = D_MODEL
HEAD_DIM = 64
ATTN_WIDTH = D_MIX // 2
N_Q_HEADS = ATTN_WIDTH // HEAD_DIM
N_KV_HEADS = 4
KV_GROUP = N_Q_HEADS // N_KV_HEADS
KV_WIDTH = N_KV_HEADS * HEAD_DIM
WINDOW = 128
BLOCK = 128
CONV_WIDTH = D_MIX // 4
CONV_K = 3
N_X_HEADS = 4
X_WIDTH = D_MIX // 4
X_HEAD_DIM = X_WIDTH // N_X_HEADS
ROPE_THETA = 10000.0
EPS = 1e-6
IN_SIZES = (ATTN_WIDTH, KV_WIDTH, KV_WIDTH, ATTN_WIDTH,
            CONV_WIDTH, CONV_WIDTH, CONV_WIDTH, CONV_WIDTH,
            X_WIDTH, X_WIDTH)
D_IN = sum(IN_SIZES)

kernel_name = "hymba_style_window_gqa_shortconv_memxattn_encoder"


def rmsnorm(x, g):
    x32 = x.astype(jnp.float32)
    y = x32 * lax.rsqrt(jnp.mean(x32 * x32, axis=-1, keepdims=True) + EPS)
    return y.astype(x.dtype) * g


def split_cols(p):
    outs, start = [], 0
    for size in IN_SIZES:
        outs.append(p[..., start:start + size])
        start += size
    return outs


def rope(x):
    s, d = x.shape[1], x.shape[-1]
    inv_freq = ROPE_THETA ** (-jnp.arange(0, d, 2, dtype=jnp.float32) / d)
    ang = jnp.arange(s, dtype=jnp.float32)[:, None] * inv_freq[None, :]
    cos = jnp.cos(ang)[None, :, None, :].astype(x.dtype)
    sin = jnp.sin(ang)[None, :, None, :].astype(x.dtype)
    x1, x2 = x[..., : d // 2], x[..., d // 2:]
    return jnp.concatenate([x1 * cos - x2 * sin, x2 * cos + x1 * sin], axis=-1)


def window_attention(q, k, v, sink):
    b, s, _, d = q.shape
    nb = s // BLOCK
    qb = q.reshape(b, nb, BLOCK, N_KV_HEADS, KV_GROUP, d)
    pad = ((0, 0), (BLOCK, BLOCK), (0, 0), (0, 0))
    kp = jnp.pad(k, pad).reshape(b, nb + 2, BLOCK, N_KV_HEADS, d)
    vp = jnp.pad(v, pad).reshape(b, nb + 2, BLOCK, N_KV_HEADS, d)
    kb = jnp.concatenate([kp[:, :-2], kp[:, 1:-1], kp[:, 2:]], axis=2)
    vb = jnp.concatenate([vp[:, :-2], vp[:, 1:-1], vp[:, 2:]], axis=2)
    scores = jnp.einsum('bnqhgd,bnkhd->bnhgqk', qb, kb).astype(jnp.float32) * (d ** -0.5)
    qpos = jnp.arange(s).reshape(nb, BLOCK)
    kpos = qpos[:, :1] - BLOCK + jnp.arange(3 * BLOCK)[None, :]
    rel = kpos[:, None, :] - qpos[:, :, None]
    valid = (jnp.abs(rel) <= WINDOW) & (kpos[:, None, :] >= 0) & (kpos[:, None, :] < s)
    scores = jnp.where(valid[None, :, None, None], scores, -jnp.inf)
    sink_logit = sink.astype(jnp.float32).reshape(N_KV_HEADS, KV_GROUP)[None, None, :, :, None, None]
    sink_logit = jnp.broadcast_to(sink_logit, scores.shape[:-1] + (1,))
    probs = jax.nn.softmax(jnp.concatenate([scores, sink_logit], axis=-1), axis=-1)[..., :-1]
    out = jnp.einsum('bnhgqk,bnkhd->bnqhgd', probs.astype(v.dtype), vb)
    return out.reshape(b, s, N_Q_HEADS * d)


def memory_attention(q, mk, mv):
    b, s = q.shape[0], q.shape[1]
    scores = jnp.einsum('bshd,bmhd->bhsm', q, mk).astype(jnp.float32) * (X_HEAD_DIM ** -0.5)
    probs = jax.nn.softmax(scores, axis=-1)
    out = jnp.einsum('bhsm,bmhd->bshd', probs.astype(mv.dtype), mv)
    return out.reshape(b, s, X_WIDTH)


def short_conv(z, conv_w):
    s = z.shape[1]
    half = CONV_K // 2
    zp = jnp.pad(z, ((0, 0), (half, half), (0, 0)))
    return sum(conv_w[t] * zp[:, t:t + s] for t in range(CONV_K))


def encoder_layer(x, mem, norm_in, w_in, sink, conv_w, norm_mem, w_mem_kv,
                  g_attn, g_conv, g_mem, w_out):
    b, s, _ = x.shape
    h = rmsnorm(x, norm_in)
    p = jnp.einsum('bsd,de->bse', h, w_in)
    q, k, v, gate_a, conv_b, conv_c, conv_h, gate_c, mq, gate_m = split_cols(p)
    q = rope(q.reshape(b, s, N_Q_HEADS, HEAD_DIM))
    k = rope(k.reshape(b, s, N_KV_HEADS, HEAD_DIM))
    v = v.reshape(b, s, N_KV_HEADS, HEAD_DIM)
    attn = rmsnorm(window_attention(q, k, v, sink), g_attn) * jax.nn.silu(gate_a)
    conv = conv_b * short_conv(conv_c * conv_h, conv_w)
    conv = rmsnorm(conv, g_conv) * jax.nn.silu(gate_c)
    mkv = jnp.einsum('bmd,de->bme', rmsnorm(mem, norm_mem), w_mem_kv)
    mk = mkv[..., :X_WIDTH].reshape(b, N_MEM, N_X_HEADS, X_HEAD_DIM)
    mv = mkv[..., X_WIDTH:].reshape(b, N_MEM, N_X_HEADS, X_HEAD_DIM)
    xo = memory_attention(mq.reshape(b, s, N_X_HEADS, X_HEAD_DIM), mk, mv)
    xo = rmsnorm(xo, g_mem) * jax.nn.silu(gate_m)
    mixed = jnp.concatenate([attn, conv, xo], axis=-1)
    return x + jnp.einsum('bse,ed->bsd', mixed, w_out)


def trunk(x, mem, norm_in, w_in, attn_sink, conv_w, norm_mem, w_mem_kv,
          g_attn, g_conv, g_mem, w_out, final_norm):
    for l in range(DEPTH):
        x = encoder_layer(x, mem, norm_in[l], w_in[l], attn_sink[l], conv_w[l], norm_mem[l],
                          w_mem_kv[l], g_attn[l], g_conv[l], g_mem[l], w_out[l])
    return rmsnorm(x, final_norm)


def setup_inputs(seed: int = 0) -> dict:
    key = jax.random.key(seed)
    ks = jax.random.split(key, 16)
    f32 = jnp.float32
    nrm = lambda k, shape, scale: jax.random.normal(k, shape, f32) * scale
    return {
        "x_prompt": nrm(ks[0], (BATCH, SEQ, D_MODEL), 1.0),
        "x_sample": nrm(ks[1], (DEC_BATCH, DEC_SEQ, D_MODEL), 1.0),
        "mem_prompt": nrm(ks[2], (BATCH, N_MEM, D_MODEL), 1.0),
        "mem_sample": nrm(ks[3], (DEC_BATCH, N_MEM, D_MODEL), 1.0),
        "norm_in": 1.0 + nrm(ks[4], (DEPTH, D_MODEL), 0.02),
        "w_in": nrm(ks[5], (DEPTH, D_MODEL, D_IN), D_MODEL ** -0.5),
        "attn_sink": nrm(ks[6], (DEPTH, N_Q_HEADS), 0.5),
        "conv_w": nrm(ks[7], (DEPTH, CONV_K, CONV_WIDTH), CONV_K ** -0.5),
        "norm_mem": 1.0 + nrm(ks[8], (DEPTH, D_MODEL), 0.02),
        "w_mem_kv": nrm(ks[9], (DEPTH, D_MODEL, 2 * X_WIDTH), D_MODEL ** -0.5),
        "g_attn": 1.0 + nrm(ks[10], (DEPTH, ATTN_WIDTH), 0.02),
        "g_conv": 1.0 + nrm(ks[11], (DEPTH, CONV_WIDTH), 0.02),
        "g_mem": 1.0 + nrm(ks[12], (DEPTH, X_WIDTH), 0.02),
        "w_out": nrm(ks[13], (DEPTH, D_MIX, D_MODEL), D_MIX ** -0.5),
        "final_norm": 1.0 + nrm(ks[14], (D_MODEL,), 0.02),
    }


def reference(x_prompt, x_sample, mem_prompt, mem_sample, norm_in, w_in, attn_sink, conv_w,
              norm_mem, w_mem_kv, g_attn, g_conv, g_mem, w_out, final_norm):
    y_prompt = trunk(x_prompt, mem_prompt, norm_in, w_in, attn_sink, conv_w, norm_mem, w_mem_kv,
                     g_attn, g_conv, g_mem, w_out, final_norm)
    y_sample = trunk(x_sample, mem_sample, norm_in, w_in, attn_sink, conv_w, norm_mem, w_mem_kv,
                     g_attn, g_conv, g_mem, w_out, final_norm)
    return (y_prompt, y_sample)
```

```cpp
#include <hip/hip_runtime.h>
#include <hip/hip_cooperative_groups.h>
#include <cstdio>
#include <cstdint>
namespace cg = cooperative_groups;

#define LAS __attribute__((address_space(3)))
#define GAS __attribute__((address_space(1)))
typedef unsigned short bf16_t;
typedef short bf16x8 __attribute__((ext_vector_type(8)));
typedef float f32x4 __attribute__((ext_vector_type(4)));
typedef float f32x2 __attribute__((ext_vector_type(2)));
typedef unsigned u32x4 __attribute__((ext_vector_type(4)));
typedef unsigned u32x2 __attribute__((ext_vector_type(2)));

constexpr int T_TOK = 32768, DM = 2048, NIN = 5632, PW = 5120, NMEM = 256, MEMROWS = 768;
constexpr float EPS = 1e-6f, LOG2E = 1.4426950408889634f;
constexpr int C_Q = 0, C_CB = 1024, C_MQ = 1536, C_K = 2048, C_V = 2304, C_GA = 2560, C_GC = 3584, C_GM = 4096, C_Z = 4608;

__device__ __forceinline__ unsigned cvt_pk_bf16(float lo, float hi) { unsigned r; asm volatile("v_cvt_pk_bf16_f32 %0, %1, %2" : "=v"(r) : "v"(lo), "v"(hi)); return r; }
__device__ __forceinline__ float bf_lo(unsigned w) { return __uint_as_float(w << 16); }
__device__ __forceinline__ float bf_hi(unsigned w) { return __uint_as_float(w & 0xffff0000u); }
__device__ __forceinline__ int lane_id_opaque() { int l; asm volatile("v_mbcnt_lo_u32_b32 %0, -1, 0\n\tv_mbcnt_hi_u32_b32 %0, -1, %0" : "=&v"(l)); return l; }
__device__ __forceinline__ float shx(float v, int lane, int mask) { return __int_as_float(__builtin_amdgcn_ds_bpermute((lane ^ mask) << 2, __float_as_int(v))); }
__device__ __forceinline__ float x32_max(float v) { auto rr = __builtin_amdgcn_permlane32_swap(__float_as_uint(v), __float_as_uint(v), false, false); return fmaxf(__uint_as_float(rr[0]), __uint_as_float(rr[1])); }
__device__ __forceinline__ float x32_sum(float v) { auto rr = __builtin_amdgcn_permlane32_swap(__float_as_uint(v), __float_as_uint(v), false, false); return __uint_as_float(rr[0]) + __uint_as_float(rr[1]); }
__device__ __forceinline__ float silu_f(float x) { return x * __builtin_amdgcn_rcpf(1.0f + __builtin_amdgcn_exp2f(-x * LOG2E)); }

namespace pg8 {
#define PG8_LAS __attribute__((address_space(3)))
typedef unsigned short bf16_t;
typedef short bf16x8 __attribute__((ext_vector_type(8)));
typedef float f32x4 __attribute__((ext_vector_type(4)));
typedef unsigned u32x4 __attribute__((ext_vector_type(4)));
constexpr int BM = 256, BK = 64, HALF = 128, HTB = HALF * BK * 2  , STAGE_BYTES = 8 * HTB, NXCD = 8, WGM = 4;
constexpr int ROWTAB_OFF = STAGE_BYTES;

__host__ __device__ __forceinline__ int lds_byte(int r, int c) { const int st = (r >> 4) * 2 + (c >> 5), rr = r & 15, cc = c & 31, ob = rr * 64 + cc * 2; return st * 1024 + (ob ^ (((ob >> 9) & 1) << 5)); }
__host__ __device__ __forceinline__ void stage_rc(int b, int& R, int& C) { const int st = b / 1024, sb = b % 1024, swz = sb ^ (((sb >> 9) & 1) << 5); R = (st >> 1) * 16 + swz / 64; C = (st & 1) * 32 + (swz % 64) / 2; }
__host__ __device__ __forceinline__ int perm32(int rho) { const int n = rho >> 4, i = rho & 15; return 8 * (i >> 2) + 4 * n + (i & 3); }

struct Unit { int pm, pn; };
struct Gemm { const bf16_t* A; const bf16_t* Bt; int M, N, K, lda; };

struct StaticOrder {
    int nM, nN, nwg, G, c;
    __host__ __device__ void init(int M, int N, int G_, int c_) { nM = M / BM; nN = N / BM; nwg = nM * nN; G = G_; c = c_; }
    __host__ __device__ bool next(int i, Unit& u) const {
        const long L = (long)i * G + c; if (L >= nwg) return false;
        int wgid = (int)L; { const int q = nwg / NXCD, r = nwg % NXCD, xcd = wgid % NXCD, off = wgid / NXCD; wgid = (xcd < r ? xcd * (q + 1) : r * (q + 1) + (xcd - r) * q) + off; }
        const int nig = WGM * nN, gid = wgid / nig, fm = gid * WGM, gsz = (nM - fm) < WGM ? (nM - fm) : WGM;
        u.pm = fm + ((wgid % nig) % gsz); u.pn = (wgid % nig) / gsz; return true;
    }
    __device__ __forceinline__ void a_ready(const Unit&) const {}
    __device__ __forceinline__ void done(const Unit&) const {}
};

struct EpiIn {
    static constexpr bool PERM = true, AFTER_DRAIN = false;
    static constexpr bool ROWTAB = true;
    bf16_t* P; const float* rowtab; const f32x2* rope;
    __device__ __forceinline__ void operator()(const f32x4 (&acc)[2][2][4][2], const Unit& u, int wr, int wc, int fr, int fq, const PG8_LAS float* tab) const {
        const int pn = u.pn; const bool is_rope = (pn < 4) || (pn == 8); const bool is_z = (pn >= 18); const float qs = (pn < 4) ? 0.125f : 1.0f;
#pragma unroll
        for (int ai = 0; ai < 2; ++ai)
#pragma unroll
            for (int m = 0; m < 4; ++m) {
                const int row = u.pm * BM + ai * HALF + wr * 64 + m * 16 + fr;
                const float rs = rsqrtf(tab[ai * HALF + wr * 64 + m * 16 + fr] * (1.0f / 2048.0f) + 1e-6f);
                const int pos = row < 16384 ? (row & 8191) : (row - 16384);
                GAS bf16_t* rowp = (GAS bf16_t*)P + (size_t)row * 5120;
                if (is_z) {
                    const f32x4 z0 = (acc[ai][0][m][0] * rs) * (acc[ai][1][m][0] * rs), z1 = (acc[ai][0][m][1] * rs) * (acc[ai][1][m][1] * rs);
                    u32x4 w; w.x = cvt_pk_bf16(z0[0], z0[1]); w.y = cvt_pk_bf16(z0[2], z0[3]); w.z = cvt_pk_bf16(z1[0], z1[1]); w.w = cvt_pk_bf16(z1[2], z1[3]);
                    *(GAS u32x4*)(rowp + 4608 + (pn - 18) * 128 + wc * 32 + 8 * fq) = w;
                    continue;
                }
#pragma unroll
                for (int bj = 0; bj < 2; ++bj) {
                    const int col0 = pn * BM + bj * HALF + wc * 32 + 8 * fq;
                    f32x4 v0 = acc[ai][bj][m][0] * rs, v1 = acc[ai][bj][m][1] * rs;
                    if (is_rope) {
                        const GAS f32x4* rp = (const GAS f32x4*)((const GAS f32x2*)rope + (size_t)pos * 32 + ((col0 & 63) >> 1));
                        const f32x4 cs0 = rp[0], cs1 = rp[1];
                        f32x4 o0, o1;
                        o0[0] = v0[0] * cs0[0] - v0[1] * cs0[1]; o0[1] = v0[1] * cs0[0] + v0[0] * cs0[1];
                        o0[2] = v0[2] * cs0[2] - v0[3] * cs0[3]; o0[3] = v0[3] * cs0[2] + v0[2] * cs0[3];
                        o1[0] = v1[0] * cs1[0] - v1[1] * cs1[1]; o1[1] = v1[1] * cs1[0] + v1[0] * cs1[1];
                        o1[2] = v1[2] * cs1[2] - v1[3] * cs1[3]; o1[3] = v1[3] * cs1[2] + v1[2] * cs1[3];
                        v0 = o0 * qs; v1 = o1 * qs;
                    }
                    {
                        u32x4 w; w.x = cvt_pk_bf16(v0[0], v0[1]); w.y = cvt_pk_bf16(v0[2], v0[3]); w.z = cvt_pk_bf16(v1[0], v1[1]); w.w = cvt_pk_bf16(v1[2], v1[3]);
                        *(GAS u32x4*)(rowp + col0) = w;
                    }
                }
            }
    }
};
struct EpiPlain {
    static constexpr bool PERM = true, AFTER_DRAIN = false;
    static constexpr bool ROWTAB = false;
    bf16_t* O; int ldc; const float* rowtab;
    __device__ __forceinline__ void operator()(const f32x4 (&acc)[2][2][4][2], const Unit& u, int wr, int wc, int fr, int fq, const PG8_LAS float*) const {
#pragma unroll
        for (int ai = 0; ai < 2; ++ai)
#pragma unroll
            for (int m = 0; m < 4; ++m) {
                const int row = u.pm * BM + ai * HALF + wr * 64 + m * 16 + fr;
#pragma unroll
                for (int bj = 0; bj < 2; ++bj) {
                    const int col0 = u.pn * BM + bj * HALF + wc * 32 + 8 * fq;
                    const f32x4 v0 = acc[ai][bj][m][0], v1 = acc[ai][bj][m][1];
                    u32x4 w; w.x = cvt_pk_bf16(v0[0], v0[1]); w.y = cvt_pk_bf16(v0[2], v0[3]); w.z = cvt_pk_bf16(v1[0], v1[1]); w.w = cvt_pk_bf16(v1[2], v1[3]);
                    *(GAS u32x4*)((GAS bf16_t*)O + (size_t)row * ldc + col0) = w;
                }
            }
    }
};
struct EpiOut {
    static constexpr bool PERM = true, AFTER_DRAIN = false, ROWTAB = true;
    const float* x0a; const float* x0b; int mode; bf16_t* XN; const float* rowtab; float* SSn;
    __device__ __forceinline__ void operator()(const f32x4 (&acc)[2][2][4][2], const Unit& u, int wr, int wc, int fr, int fq, const PG8_LAS float* tab) const {
#pragma unroll
        for (int ai = 0; ai < 2; ++ai)
#pragma unroll
            for (int m = 0; m < 4; ++m) {
                const int row = u.pm * BM + ai * HALF + wr * 64 + m * 16 + fr;
                const float ra = tab[ai * HALF + wr * 64 + m * 16 + fr];
                const GAS float* xo = (const GAS float*)(row < 16384 ? x0a + (size_t)row * 2048 : x0b + (size_t)(row - 16384) * 2048);
                GAS bf16_t* xr = (GAS bf16_t*)XN + (size_t)row * 2048;
                float ssq = 0.f;
#pragma unroll
                for (int bj = 0; bj < 2; ++bj) {
                    const int col0 = u.pn * BM + bj * HALF + wc * 32 + 8 * fq;
                    f32x4 a0, a1;
                    if (mode == 0) { a0 = *(const GAS f32x4*)(xo + col0); a1 = *(const GAS f32x4*)(xo + col0 + 4); }
                    else { const u32x4 w = *(const GAS u32x4*)(xr + col0);
                        a0 = (f32x4){bf_lo(w.x), bf_hi(w.x), bf_lo(w.y), bf_hi(w.y)}; a1 = (f32x4){bf_lo(w.z), bf_hi(w.z), bf_lo(w.w), bf_hi(w.w)}; }
                    const f32x4 v0 = a0 + acc[ai][bj][m][0] * ra, v1 = a1 + acc[ai][bj][m][1] * ra;
                    ssq += (v0[0] * v0[0] + v0[1] * v0[1]) + (v0[2] * v0[2] + v0[3] * v0[3]) + (v1[0] * v1[0] + v1[1] * v1[1]) + (v1[2] * v1[2] + v1[3] * v1[3]);
                    u32x4 w; w.x = cvt_pk_bf16(v0[0], v0[1]); w.y = cvt_pk_bf16(v0[2], v0[3]); w.z = cvt_pk_bf16(v1[0], v1[1]); w.w = cvt_pk_bf16(v1[2], v1[3]);
                    *(GAS u32x4*)(xr + col0) = w;
                }
                { const int ln = fr + 16 * fq; ssq += shx(ssq, ln, 16); ssq = x32_sum(ssq); }
                if (fq == 0) unsafeAtomicAdd(SSn + row, ssq);
            }
    }
};

template <class Epi, class Sched, bool ALIGN_EPI = false, bool SP2 = true>
__device__ __forceinline__ void gemm_phase(PG8_LAS unsigned char* lds, const Gemm g, const Sched& S, const Epi& E, int wave_s) {
    int tid_ = wave_s * 64 + lane_id_opaque(); asm volatile("" : "+v"(tid_));
    const int tid = tid_, wid = __builtin_amdgcn_readfirstlane(tid >> 6), lane = tid & 63, wr = wid >> 2, wc = wid & 3, fr = lane & 15, fq = lane >> 4;
    const int K = g.K, nt = K / BK, lda = g.lda;
    unsigned voffA[2], voffB[2];
#pragma unroll
    for (int i = 0; i < 2; ++i) { int R, C; stage_rc(tid * 16 + i * 8192, R, C); const int Rb = Epi::PERM ? ((R & ~31) + perm32(R & 31)) : R;
        voffA[i] = (unsigned)(R * lda + C) * 2u; voffB[i] = (unsigned)(Rb * K + C) * 2u; }
    const size_t kstep = (size_t)(BK * 2);
    const size_t hstepA = (size_t)HALF * lda * 2, hstepB = (size_t)HALF * K * 2;
    const size_t tstepA = 2 * hstepA, tstepB = 2 * hstepB;
    const unsigned ldsw = (unsigned)wid * 1024u;
    const int aoff = lds_byte(wr * 64 + fr, fq * 8), boff = lds_byte(wc * 32 + fr, fq * 8);
#define PG8_SA(b, h) (((b) * 2 + (h)) * HTB)
#define PG8_SB(b, h) ((4 + (b) * 2 + (h)) * HTB)
#define PG8_STAGE(bufoff, gbase, voff) do { _Pragma("unroll") for (int _i = 0; _i < 2; ++_i) \
        __builtin_amdgcn_global_load_lds((const unsigned*)((const char*)(gbase) + (voff)[_i]), (PG8_LAS unsigned*)(lds + (bufoff) + ldsw + _i * 8192), 16, 0, 0); } while (0)
#define PG8_LDA(dst, b, h) do { _Pragma("unroll") for (int m = 0; m < 4; ++m) _Pragma("unroll") for (int k = 0; k < 2; ++k) dst[m][k] = *(const PG8_LAS bf16x8*)(lds + PG8_SA(b, h) + aoff + m * 2048 + k * 1024); } while (0)
#define PG8_LDB(dst, b, h) do { _Pragma("unroll") for (int n = 0; n < 2; ++n) _Pragma("unroll") for (int k = 0; k < 2; ++k) dst[n][k] = *(const PG8_LAS bf16x8*)(lds + PG8_SB(b, h) + boff + n * 2048 + k * 1024); } while (0)
#define PG8_MMA(ai, bj, At, Bt) do { __builtin_amdgcn_s_setprio(1); _Pragma("unroll") for (int m = 0; m < 4; ++m) _Pragma("unroll") for (int n = 0; n < 2; ++n) _Pragma("unroll") for (int k = 0; k < 2; ++k) \
        acc[ai][bj][m][n] = __builtin_amdgcn_mfma_f32_16x16x32_bf16(Bt[n][k], At[m][k], acc[ai][bj][m][n], 0, 0, 0); __builtin_amdgcn_s_setprio(0); } while (0)
#define PG8_WAIT_V(n) asm volatile("s_waitcnt vmcnt(" #n ")" ::: "memory")
#define PG8_WAIT_L(n) asm volatile("s_waitcnt lgkmcnt(" #n ")" ::: "memory")
#define PG8_BAR __builtin_amdgcn_s_barrier()
#define PG8_SCHED __builtin_amdgcn_sched_barrier(0)
    Unit cur, nxt; int ui = 0;
    if (!S.next(0, cur)) return;
    f32x4 acc[2][2][4][2];
#pragma unroll
    for (int a = 0; a < 2; ++a)
#pragma unroll
        for (int b = 0; b < 2; ++b)
#pragma unroll
            for (int m = 0; m < 4; ++m)
#pragma unroll
                for (int n = 0; n < 2; ++n) acc[a][b][m][n] = (f32x4){0.f, 0.f, 0.f, 0.f};
    bf16x8 At[4][2], B0[2][2], B1[2][2];
    const char* cA = (const char*)g.A + (size_t)cur.pm * tstepA; const char* cB = (const char*)g.Bt + (size_t)cur.pn * tstepB;
    S.a_ready(cur);
    if constexpr (SP2) {
        PG8_STAGE(PG8_SB(0, 0), cB, voffB); PG8_STAGE(PG8_SB(0, 1), cB + hstepB, voffB); PG8_STAGE(PG8_SA(0, 0), cA, voffA); PG8_STAGE(PG8_SA(0, 1), cA + hstepA, voffA);
        if (wr == 1) PG8_BAR;
        PG8_WAIT_V(2); PG8_BAR;
        PG8_STAGE(PG8_SB(1, 0), cB + kstep, voffB); PG8_STAGE(PG8_SA(1, 0), cA + kstep, voffA); PG8_STAGE(PG8_SB(1, 1), cB + hstepB + kstep, voffB);
        PG8_WAIT_V(6); PG8_BAR;
    } else {
        PG8_STAGE(PG8_SB(0, 0), cB, voffB); PG8_STAGE(PG8_SA(0, 0), cA, voffA); PG8_STAGE(PG8_SB(0, 1), cB + hstepB, voffB); PG8_STAGE(PG8_SA(0, 1), cA + hstepA, voffA);
        if (wr == 1) PG8_BAR;
        PG8_WAIT_V(4); PG8_BAR;
        PG8_STAGE(PG8_SB(1, 0), cB + kstep, voffB); PG8_STAGE(PG8_SA(1, 0), cA + kstep, voffA); PG8_STAGE(PG8_SB(1, 1), cB + hstepB + kstep, voffB);
        PG8_WAIT_V(6); PG8_BAR;
    }
    for (;;) {
        const bool has_next = S.next(ui + 1, nxt);
        const char* nA = has_next ? (const char*)g.A + (size_t)nxt.pm * tstepA : cA; const char* nB = has_next ? (const char*)g.Bt + (size_t)nxt.pn * tstepB : cB;
        if (Epi::ROWTAB && wid < 4)
            __builtin_amdgcn_global_load_lds((const GAS unsigned*)((const GAS char*)(E.rowtab + cur.pm * BM + wid * 64) + (size_t)(unsigned)(lane_id_opaque() * 4)), (PG8_LAS unsigned*)(lds + ROWTAB_OFF + (ui & 1) * 1024 + wid * 256), 4, 0, 0);
        for (int t = 0; t < nt; t += 2) {
            const bool last = (t == nt - 2);
            const char* a1 = cA + (size_t)(t + 1) * kstep;
            const char* a2 = last ? nA : cA + (size_t)(t + 2) * kstep; const char* b2 = last ? nB : cB + (size_t)(t + 2) * kstep;
            const char* a3 = a2 + kstep; const char* b3 = b2 + kstep;
            if (last && has_next) S.a_ready(nxt);
            if constexpr (SP2) {
            PG8_LDB(B0, 0, 0); PG8_LDB(B1, 0, 1); PG8_SCHED; PG8_LDA(At, 0, 0); PG8_STAGE(PG8_SA(1, 1), a1 + hstepA, voffA);
            PG8_WAIT_V(8); PG8_WAIT_L(0); PG8_BAR; PG8_MMA(0, 0, At, B0); PG8_MMA(0, 1, At, B1); PG8_BAR; PG8_SCHED;
            PG8_LDA(At, 0, 1); PG8_STAGE(PG8_SB(0, 0), b2, voffB); PG8_STAGE(PG8_SB(0, 1), b2 + hstepB, voffB); PG8_STAGE(PG8_SA(0, 0), a2, voffA);
            PG8_WAIT_V(8); PG8_WAIT_L(0); PG8_BAR; PG8_MMA(1, 0, At, B0); PG8_MMA(1, 1, At, B1); PG8_BAR; PG8_SCHED;
            PG8_LDB(B0, 1, 0); PG8_LDB(B1, 1, 1); PG8_SCHED; PG8_LDA(At, 1, 0); PG8_STAGE(PG8_SA(0, 1), a2 + hstepA, voffA);
            PG8_WAIT_V(8); PG8_WAIT_L(0); PG8_BAR; PG8_MMA(0, 0, At, B0); PG8_MMA(0, 1, At, B1); PG8_BAR; PG8_SCHED;
            PG8_LDA(At, 1, 1); PG8_STAGE(PG8_SB(1, 0), b3, voffB); PG8_STAGE(PG8_SB(1, 1), b3 + hstepB, voffB); PG8_STAGE(PG8_SA(1, 0), a3, voffA);
            PG8_WAIT_V(8); PG8_WAIT_L(0); PG8_BAR; PG8_MMA(1, 0, At, B0); PG8_MMA(1, 1, At, B1); PG8_BAR; PG8_SCHED;
            } else {
            PG8_LDB(B0, 0, 0); PG8_SCHED; PG8_LDA(At, 0, 0); PG8_STAGE(PG8_SA(1, 1), a1 + hstepA, voffA);
            PG8_WAIT_L(8); PG8_BAR; PG8_WAIT_L(0); PG8_MMA(0, 0, At, B0); PG8_BAR; PG8_SCHED;
            PG8_LDB(B1, 0, 1); PG8_STAGE(PG8_SB(0, 0), b2, voffB);
            PG8_BAR; PG8_WAIT_L(0); PG8_MMA(0, 1, At, B1); PG8_BAR;
            PG8_LDA(At, 0, 1); PG8_STAGE(PG8_SA(0, 0), a2, voffA);
            PG8_BAR; PG8_WAIT_L(0); PG8_MMA(1, 0, At, B0); PG8_BAR; PG8_SCHED;
            PG8_STAGE(PG8_SB(0, 1), b2 + hstepB, voffB);
            PG8_WAIT_V(6); PG8_BAR; PG8_MMA(1, 1, At, B1); PG8_BAR;
            PG8_LDB(B0, 1, 0); PG8_SCHED; PG8_LDA(At, 1, 0); PG8_STAGE(PG8_SA(0, 1), a2 + hstepA, voffA);
            PG8_WAIT_L(8); PG8_BAR; PG8_WAIT_L(0); PG8_MMA(0, 0, At, B0); PG8_BAR; PG8_SCHED;
            PG8_LDB(B1, 1, 1); PG8_STAGE(PG8_SB(1, 0), b3, voffB);
            PG8_BAR; PG8_WAIT_L(0); PG8_MMA(0, 1, At, B1); PG8_BAR;
            PG8_LDA(At, 1, 1); PG8_STAGE(PG8_SA(1, 0), a3, voffA);
            PG8_BAR; PG8_WAIT_L(0); PG8_MMA(1, 0, At, B0); PG8_BAR; PG8_SCHED;
            PG8_STAGE(PG8_SB(1, 1), b3 + hstepB, voffB);
            PG8_WAIT_V(6); PG8_BAR; PG8_MMA(1, 1, At, B1); PG8_BAR;
            }
        }
        if constexpr (ALIGN_EPI) { if (wr == 0) PG8_BAR; }
        if constexpr (!Epi::AFTER_DRAIN) { E(acc, cur, wr, wc, fr, fq, (const PG8_LAS float*)(lds + ROWTAB_OFF + (ui & 1) * 1024)); S.done(cur); }
        if (!has_next) break;
#pragma unroll
        for (int a = 0; a < 2; ++a)
#pragma unroll
            for (int b = 0; b < 2; ++b)
#pragma unroll
                for (int m = 0; m < 4; ++m)
#pragma unroll
                    for (int n = 0; n < 2; ++n) acc[a][b][m][n] = (f32x4){0.f, 0.f, 0.f, 0.f};
        cur = nxt; cA = nA; cB = nB; ++ui;
        if constexpr (ALIGN_EPI) { if (wr == 1) PG8_BAR; }
    }
    PG8_WAIT_V(0);
    if constexpr (!ALIGN_EPI) { if (wr == 0) PG8_BAR; }
    PG8_BAR;
    if constexpr (Epi::AFTER_DRAIN) { E.fused(acc, cur, wr, wc, fr, fq, lds, wid, lane); S.done(cur); }
#undef PG8_SA
#undef PG8_SB
#undef PG8_STAGE
#undef PG8_LDA
#undef PG8_LDB
#undef PG8_MMA
#undef PG8_WAIT_V
#undef PG8_WAIT_L
#undef PG8_BAR
#undef PG8_SCHED
}
}

constexpr size_t WS_P = 0, WS_XN = 335544320ull, WS_WOUT = 469762048ull, WS_WIN1 = 486539264ull, WS_MKV = 509607936ull, WS_ROPE = 512753664ull, WS_SS = 516947968ull, WS_END = 517472256ull;
constexpr size_t DO_WIN0 = 0, DO_WMKV = 23068672ull, DO_MEMN = 31457280ull;
constexpr int LDS_BYTES = 147456;
constexpr int L_K = 0, L_VT = 49152, L_KM = 0, L_VM = 65536, L_RA = 131072, L_SSQ = 131584;
constexpr int NTHREADS = 512;
constexpr size_t WS_CTL = WS_END + 4096, CTL_BYTES = 16384;
constexpr int L_MISC = 147392;

struct Params {
    const float* x_prompt; const float* x_sample; const float* mem_prompt; const float* mem_sample;
    const float* norm_in; const float* w_in; const float* sink; const float* conv_w; const float* norm_mem; const float* w_mem_kv;
    const float* g_attn; const float* g_conv; const float* g_mem; const float* w_out; const float* final_norm;
    float* out; unsigned char* ws;
};

__device__ const double INVF_REV[32] = {0.15915494309189535, 0.11934937021124886, 0.08949940160889101, 0.06711508300522726, 0.050329212104487035, 0.03774158471741977, 0.0283021958306234, 0.02122365276477766, 0.015915494309189534, 0.011934937021124886, 0.008949940160889102, 0.006711508300522725, 0.005032921210448704, 0.003774158471741977, 0.00283021958306234, 0.0021223652764777662, 0.0015915494309189536, 0.0011934937021124885, 0.0008949940160889102, 0.0006711508300522726, 0.0005032921210448703, 0.00037741584717419774, 0.00028302195830623395, 0.0002122365276477766, 0.00015915494309189535, 0.00011934937021124886, 8.949940160889102e-05, 6.711508300522725e-05, 5.0329212104487035e-05, 3.774158471741978e-05, 2.8302195830623396e-05, 2.122365276477766e-05};

__device__ __forceinline__ float wave_sum(float v, int lane) {
#pragma unroll
    for (int o = 1; o < 64; o <<= 1) v += shx(v, lane, o);
    return v;
}

__device__ __forceinline__ int win_map(int n) {
    if (n < 1024) { const int d = n & 63; return (n & ~63) + 2 * (d & 31) + (d >> 5); }
    if (n < 1280) { const int q = n - 1024, d = q & 63; return 2048 + (q & ~63) + 2 * (d & 31) + (d >> 5); }
    if (n < 1536) return 2304 + (n - 1280);
    if (n < 2560) return 2560 + (n - 1536);
    if (n < 3072) return 1024 + (n - 2560);
    if (n < 3584) { const int ch = n - 3072; return 4608 + 256 * (ch >> 7) + (ch & 127); }
    if (n < 4096) { const int ch = n - 3584; return 4608 + 256 * (ch >> 7) + 128 + (ch & 127); }
    if (n < 4608) return 3584 + (n - 4096);
    if (n < 5120) return 1536 + (n - 4608);
    return 4096 + (n - 5120);
}
template <bool MAPIN>
__device__ __forceinline__ void transpose_item(const float* W, int K, int N, bf16_t* WT, LAS float* scr, int item, int lane, const float* gk = nullptr) {
    const int nblk = N / 32, kb = item / nblk, nb = item % nblk, k0 = 64 * kb, n0 = 32 * nb;
#pragma unroll 8
    for (int i = 0; i < 32; ++i) { const int kk = 2 * i + (lane >> 5); scr[kk * 33 + (lane & 31)] = W[(size_t)(k0 + kk) * N + n0 + (lane & 31)]; }
    asm volatile("s_waitcnt lgkmcnt(0)" ::: "memory");
    const int c = lane & 7;
#pragma unroll
    for (int j = 0; j < 4; ++j) { const int n = (lane >> 3) + 8 * j; const LAS float* s = scr + (8 * c) * 33 + n;
        f32x4 ga = (f32x4){1.f, 1.f, 1.f, 1.f}, gb = ga;
        if (gk) { ga = *(const f32x4*)(gk + k0 + 8 * c); gb = *(const f32x4*)(gk + k0 + 8 * c + 4); }
        u32x4 o; o.x = cvt_pk_bf16(s[0 * 33] * ga[0], s[1 * 33] * ga[1]); o.y = cvt_pk_bf16(s[2 * 33] * ga[2], s[3 * 33] * ga[3]); o.z = cvt_pk_bf16(s[4 * 33] * gb[0], s[5 * 33] * gb[1]); o.w = cvt_pk_bf16(s[6 * 33] * gb[2], s[7 * 33] * gb[3]);
        const int nd = MAPIN ? win_map(n0 + n) : (n0 + n);
        *(u32x4*)(WT + (size_t)nd * K + k0 + 8 * c) = o; }
    asm volatile("s_waitcnt lgkmcnt(0)" ::: "memory");
}

__device__ __forceinline__ void p0_prologue(const Params& p, LAS unsigned char* lds, int vcu_in, int G_in, int cu0, int part) {
    const int tid = threadIdx.x, lane = tid & 63, wave = tid >> 6;
    const int vcu = vcu_in - cu0, G = G_in - cu0;
    if (vcu < 0) return;
    const int gw = vcu * 8 + wave, NGW = G * 8;
    unsigned char* ws = p.ws; unsigned char* dob = (unsigned char*)p.out;
    {
        LAS float* scr = (LAS float*)(lds + wave * 16384);
        constexpr int I_IN = 32 * 176, I_OUT = 32 * 64, I_MKV = 32 * 32, I_L = I_IN + I_OUT;
        if (part == 0) {
            for (int it = gw; it < 2 * I_MKV; it += NGW) { const int l = it / I_MKV, r = it % I_MKV;
                transpose_item<false>(p.w_mem_kv + (size_t)l * 2048 * 1024, 2048, 1024, (bf16_t*)(dob + DO_WMKV) + (size_t)l * 1024 * 2048, scr, r, lane); }
        } else
        for (int it = gw; it < 2 * I_L; it += NGW) {
            const int l = it / I_L; int r = it % I_L;
            if (r < I_IN) { bf16_t* dst = l == 0 ? (bf16_t*)(dob + DO_WIN0) : (bf16_t*)(ws + WS_WIN1);
                transpose_item<true>(p.w_in + (size_t)l * 2048 * 5632, 2048, 5632, dst, scr, r, lane, l == 1 ? p.norm_in + 2048 : nullptr); continue; }
            r -= I_IN;
            { const int k0 = 64 * (r / 64);
              const float* gk = k0 < 1024 ? p.g_attn + l * 1024 : (k0 < 1536 ? p.g_conv + l * 512 - 1024 : p.g_mem + l * 512 - 1536);
              transpose_item<false>(p.w_out + (size_t)l * 2048 * 2048, 2048, 2048, (bf16_t*)(ws + WS_WOUT) + (size_t)l * 2048 * 2048, scr, r, lane, gk); }
        }
    }
    if (part == 1) {
        float* SS0 = (float*)(ws + WS_SS); float* SS1 = SS0 + 32768; float* SSF = SS0 + 65536;
        for (int i = vcu * NTHREADS + tid; i < 32768; i += G * NTHREADS) { SS1[i] = 0.f; SSF[i] = 0.f; }
        f32x4 g[8];
#pragma unroll
        for (int j = 0; j < 8; ++j) g[j] = ((const f32x4*)p.norm_in)[lane + 64 * j];
        bf16_t* XN = (bf16_t*)(ws + WS_XN);
        for (int row = gw; row < T_TOK; row += NGW) {
            const float* xr = row < 16384 ? p.x_prompt + (size_t)row * 2048 : p.x_sample + (size_t)(row - 16384) * 2048;
            f32x4 v[8]; float s = 0.f;
#pragma unroll
            for (int j = 0; j < 8; ++j) { v[j] = ((const f32x4*)xr)[lane + 64 * j]; s += (v[j][0] * v[j][0] + v[j][1] * v[j][1]) + (v[j][2] * v[j][2] + v[j][3] * v[j][3]); }
            s = wave_sum(s, lane);
            if (lane == 0) SS0[row] = s;
            u32x2* o = (u32x2*)(XN + (size_t)row * 2048);
#pragma unroll
            for (int j = 0; j < 8; ++j) { const f32x4 y = v[j] * g[j]; u32x2 w; w.x = cvt_pk_bf16(y[0], y[1]); w.y = cvt_pk_bf16(y[2], y[3]); o[lane + 64 * j] = w; }
        }
    }
    if (part == 0) for (int row = gw; row < MEMROWS; row += NGW) {
        const float* xr = row < 512 ? p.mem_prompt + (size_t)row * 2048 : p.mem_sample + (size_t)(row - 512) * 2048;
        f32x4 v[8]; float s = 0.f;
#pragma unroll
        for (int j = 0; j < 8; ++j) { v[j] = ((const f32x4*)xr)[lane + 64 * j]; s += (v[j][0] * v[j][0] + v[j][1] * v[j][1]) + (v[j][2] * v[j][2] + v[j][3] * v[j][3]); }
        s = wave_sum(s, lane);
        const float rs = rsqrtf(s * (1.0f / 2048.0f) + EPS);
#pragma unroll
        for (int l = 0; l < 2; ++l) {
            u32x2* o = (u32x2*)((bf16_t*)(dob + DO_MEMN) + ((size_t)l * MEMROWS + row) * 2048);
#pragma unroll
            for (int j = 0; j < 8; ++j) { const f32x4 gg = ((const f32x4*)(p.norm_mem + l * 2048))[lane + 64 * j]; const f32x4 y = v[j] * rs * gg;
                u32x2 w; w.x = cvt_pk_bf16(y[0], y[1]); w.y = cvt_pk_bf16(y[2], y[3]); o[lane + 64 * j] = w; }
        }
    }
    if (part == 1) {
        f32x2* rope = (f32x2*)(ws + WS_ROPE);
        for (int i = vcu * NTHREADS + tid; i < 16384 * 32; i += G * NTHREADS) {
            const int pos = i >> 5, fi = i & 31;
            const double rev = (double)pos * INVF_REV[fi];
            const float fr = (float)(rev - __builtin_rint(rev));
            f32x2 cs; cs[0] = __builtin_amdgcn_cosf(fr); cs[1] = __builtin_amdgcn_sinf(fr);
            rope[i] = cs;
        }
    }
}

typedef short v4i16_t __attribute__((ext_vector_type(4)));
#define LBAR() do { asm volatile("s_waitcnt lgkmcnt(0)" ::: "memory"); __builtin_amdgcn_s_barrier(); asm volatile("" ::: "memory"); } while (0)
#define PG(T, BASE, off_elems) (*(GAS T*)((GAS char*)(BASE) + (size_t)((unsigned)(off_elems) * 2u)))
__device__ __forceinline__ void glds16(const GAS void* gsrc, unsigned lds_dst) { unsigned keep;
    asm volatile("s_mov_b32 %0, m0\n\ts_mov_b32 m0, %2\n\ts_nop 0\n\tglobal_load_lds_dwordx4 %1, off\n\ts_mov_b32 m0, %0" : "=&s"(keep) : "v"(gsrc), "s"(lds_dst) : "memory"); }
__device__ __forceinline__ int slot_of(int kappa) { const int kq = kappa & 31; return (kappa & ~31) + 16 * ((kq >> 2) & 1) + 4 * (kq >> 3) + (kq & 3); }
__device__ __forceinline__ v4i16_t tr16(LAS unsigned char* a) { return __builtin_amdgcn_ds_read_tr16_b64_v4i16((LAS v4i16_t*)a); }

__device__ __forceinline__ void load_z8(const GAS bf16_t* P, int t, int s0, int s1, int lane, float (&z)[8]) {
    if (t >= s0 && t < s1) { const u32x4 v = *(const GAS u32x4*)(P + (size_t)t * PW + C_Z + 8 * lane);
        z[0] = bf_lo(v.x); z[1] = bf_hi(v.x); z[2] = bf_lo(v.y); z[3] = bf_hi(v.y); z[4] = bf_lo(v.z); z[5] = bf_hi(v.z); z[6] = bf_lo(v.w); z[7] = bf_hi(v.w); }
    else {
#pragma unroll
        for (int j = 0; j < 8; ++j) z[j] = 0.f; }
}

__device__ __forceinline__ void mixer_unit(const Params& p, LAS unsigned char* lds, int tile, int layer, int wave_s) {
    int tid_ = wave_s * 64 + lane_id_opaque(); asm volatile("" : "+v"(tid_));
    const int tid = tid_, lane = tid & 63, wave = __builtin_amdgcn_readfirstlane(tid >> 6), rho = lane & 15, g = lane >> 4;
    unsigned char* wsb = p.ws; asm volatile("" : "+s"(wsb));
    GAS bf16_t* P = (GAS bf16_t*)(wsb + WS_P);
    const int tile0 = tile * 128;
    int s0, s1, ms;
    if (tile0 < 8192) { s0 = 0; s1 = 8192; ms = 0; } else if (tile0 < 16384) { s0 = 8192; s1 = 16384; ms = 1; } else { s0 = 16384; s1 = 32768; ms = 2; }
    const bool first = (tile0 == s0), last = (tile0 + 128 == s1);
    LAS float* RAs = (LAS float*)(lds + L_RA);
    LAS float* SSQ = (LAS float*)(lds + L_SSQ);
    const GAS float* sinkp = (const GAS float*)p.sink + layer * 16;

    const bf16x8 ONES8 = (bf16x8){0x3F80, 0x3F80, 0x3F80, 0x3F80, 0x3F80, 0x3F80, 0x3F80, 0x3F80};
    if (wave >= 4) __builtin_amdgcn_s_setprio(1);
    {
        const int fv = (rho >> 2) | ((g & 1) << 2);
        const int vlane = (8 * g + (rho >> 2)) * 128;
        u32x4 kreg[6], vreg[6];
#define WIN_PREFETCH(KVH) do { _Pragma("unroll") for (int j = 0; j < 6; ++j) { \
                const int idx = tid + NTHREADS * j, kap = idx >> 3, ch = idx & 7, trow = tile0 - 128 + kap; \
                const bool ok = (trow >= s0 && trow < s1); const unsigned tr_c = (unsigned)(ok ? trow : tile0); \
                const unsigned so = tr_c * (unsigned)PW + (unsigned)((KVH) * 64 + ch * 8); \
                const u32x4 kk = PG(const u32x4, P, so + C_K), vv = PG(const u32x4, P, so + C_V); \
                kreg[j] = ok ? kk : (u32x4){0u, 0u, 0u, 0u}; vreg[j] = ok ? vv : (u32x4){0u, 0u, 0u, 0u}; } } while (0)
        WIN_PREFETCH(0);
        const bool inv_lo = first, inv_hi = last;
        bf16x8 qf[2];
        {
            const unsigned q0 = (unsigned)(tile0 + (wave & 1) * 64 + rho) * (unsigned)PW + (unsigned)(C_Q + (wave >> 1) * 64 + 8 * g);
            qf[0] = PG(const bf16x8, P, q0); qf[1] = PG(const bf16x8, P, q0 + 32);
        }
        for (int kvh = 0; kvh < 4; ++kvh) {
            const int hq = kvh * 4 + (wave >> 1), rhalf = (wave & 1) * 64;
            LBAR();
#pragma unroll
            for (int j = 0; j < 6; ++j) {
                const int idx = tid + NTHREADS * j, kap = idx >> 3, ch = idx & 7;
                const int sl = slot_of(kap);
                *(LAS u32x4*)(lds + L_K + sl * 128 + ((ch ^ (sl & 7)) << 4)) = kreg[j];
                const int fk = (kap & 3) | (((kap >> 3) & 1) << 2);
                *(LAS u32x4*)(lds + L_VT + kap * 128 + ((ch ^ fk) << 4)) = vreg[j];
            }
            LBAR();
#ifndef NO_WPF
            if (kvh < 3) WIN_PREFETCH(kvh + 1);
#endif
            const float sink = sinkp[hq];
#pragma unroll 1
            for (int qt = 0; qt < 4; ++qt) {
                const int a = rhalf + 16 * qt, trow = tile0 + a + rho;
                const unsigned prow = (unsigned)trow * (unsigned)PW + (unsigned)(hq * 64 + 8 * g);
                u32x4 gt[2];
#pragma unroll
                for (int j = 0; j < 2; ++j) gt[j] = PG(const u32x4, P, prow + C_GA + 32 * j);
                bf16x8 qn[2];
                {
                    const unsigned q1 = (unsigned)(tile0 + rhalf + 16 * ((qt + 1) & 3) + rho) * (unsigned)PW + (unsigned)(C_Q + (qt == 3 ? hq + 4 : hq) * 64 + 8 * g);
                    qn[0] = PG(const bf16x8, P, q1); qn[1] = PG(const bf16x8, P, q1 + 32);
                }
                const int beta0 = a >> 5, qq = (a & 31) + rho;
                f32x4 S[9][2];
#pragma unroll
                for (int c = 0; c < 9; ++c) {
                    const int beta = beta0 + c;
#pragma unroll
                    for (int w = 0; w < 2; ++w) {
                        const int sl = 32 * beta + 16 * w + rho;
                        const bf16x8 k0 = *(const LAS bf16x8*)(lds + L_K + sl * 128 + ((g ^ (sl & 7)) << 4));
                        const bf16x8 k1 = *(const LAS bf16x8*)(lds + L_K + sl * 128 + (((4 + g) ^ (sl & 7)) << 4));
                        f32x4 acc = (f32x4){0.f, 0.f, 0.f, 0.f};
                        acc = __builtin_amdgcn_mfma_f32_16x16x32_bf16(k0, qf[0], acc, 0, 0, 0);
                        acc = __builtin_amdgcn_mfma_f32_16x16x32_bf16(k1, qf[1], acc, 0, 0, 0);
                        S[c][w] = acc;
                    }
                    if (c == 0) {
#pragma unroll
                        for (int w = 0; w < 2; ++w)
#pragma unroll
                            for (int r = 0; r < 4; ++r) S[c][w][r] = (8 * g + 4 * w + r < qq) ? -INFINITY : S[c][w][r];
                    }
                    if (c == 8) {
#pragma unroll
                        for (int w = 0; w < 2; ++w)
#pragma unroll
                            for (int r = 0; r < 4; ++r) S[c][w][r] = (8 * g + 4 * w + r > qq) ? -INFINITY : S[c][w][r];
                    }
                }
                if (inv_lo || inv_hi) {
#pragma unroll
                    for (int c = 0; c < 9; ++c) {
                        const int beta = beta0 + c;
                        const bool cinv = (inv_lo && beta < 4) || (inv_hi && beta >= 8);
#pragma unroll
                        for (int w = 0; w < 2; ++w)
#pragma unroll
                            for (int r = 0; r < 4; ++r) S[c][w][r] = cinv ? -INFINITY : S[c][w][r];
                    }
                }
                float mx = sink;
#pragma unroll
                for (int c = 0; c < 9; ++c)
#pragma unroll
                    for (int w = 0; w < 2; ++w) { mx = __builtin_fmaxf(__builtin_fmaxf(mx, S[c][w][0]), S[c][w][1]); mx = __builtin_fmaxf(__builtin_fmaxf(mx, S[c][w][2]), S[c][w][3]); }
                mx = fmaxf(mx, shx(mx, lane, 16)); mx = x32_max(mx);
                const float mb = mx * LOG2E;
#pragma unroll
                for (int c = 0; c < 9; ++c)
#pragma unroll
                    for (int w = 0; w < 2; ++w)
#pragma unroll
                        for (int r = 0; r < 4; ++r) S[c][w][r] = __builtin_amdgcn_exp2f(S[c][w][r] * LOG2E - mb);
                f32x4 OS = (f32x4){0.f, 0.f, 0.f, 0.f};
                f32x4 O[4];
#pragma unroll
                for (int dt = 0; dt < 4; ++dt) O[dt] = (f32x4){0.f, 0.f, 0.f, 0.f};
#pragma unroll
                for (int c = 0; c < 9; ++c) {
                    const int beta = beta0 + c;
                    u32x4 pw; pw.x = cvt_pk_bf16(S[c][0][0], S[c][0][1]); pw.y = cvt_pk_bf16(S[c][0][2], S[c][0][3]); pw.z = cvt_pk_bf16(S[c][1][0], S[c][1][1]); pw.w = cvt_pk_bf16(S[c][1][2], S[c][1][3]);
                    const bf16x8 pf = __builtin_bit_cast(bf16x8, pw);
                    LAS unsigned char* vb = lds + L_VT + vlane + beta * 4096;
                    OS = __builtin_amdgcn_mfma_f32_16x16x32_bf16(ONES8, pf, OS, 0, 0, 0);
#pragma unroll
                    for (int dt = 0; dt < 4; ++dt) {
                        const int co = (((4 * (dt >> 1) + (rho & 3)) ^ fv) << 4) + 8 * (dt & 1);
                        const v4i16_t lo = tr16(vb + co), hi = tr16(vb + 512 + co);
                        const bf16x8 vf = (bf16x8){lo[0], lo[1], lo[2], lo[3], hi[0], hi[1], hi[2], hi[3]};
                        O[dt] = __builtin_amdgcn_mfma_f32_16x16x32_bf16(vf, pf, O[dt], 0, 0, 0);
                    }
                }
                const float il = __builtin_amdgcn_rcpf(OS[0] + __builtin_amdgcn_exp2f(sink * LOG2E - mb));
                float ssq = 0.f;
#pragma unroll
                for (int j = 0; j < 2; ++j) {
                    const f32x4 o0 = O[2 * j] * il, o1 = O[2 * j + 1] * il;
                    ssq += (o0[0] * o0[0] + o0[1] * o0[1]) + (o0[2] * o0[2] + o0[3] * o0[3]) + (o1[0] * o1[0] + o1[1] * o1[1]) + (o1[2] * o1[2] + o1[3] * o1[3]);
                    u32x4 w;
                    w.x = cvt_pk_bf16(o0[0] * silu_f(bf_lo(gt[j].x)), o0[1] * silu_f(bf_hi(gt[j].x)));
                    w.y = cvt_pk_bf16(o0[2] * silu_f(bf_lo(gt[j].y)), o0[3] * silu_f(bf_hi(gt[j].y)));
                    w.z = cvt_pk_bf16(o1[0] * silu_f(bf_lo(gt[j].z)), o1[1] * silu_f(bf_hi(gt[j].z)));
                    w.w = cvt_pk_bf16(o1[2] * silu_f(bf_lo(gt[j].w)), o1[3] * silu_f(bf_hi(gt[j].w)));
                    PG(u32x4, P, prow + C_Q + 32 * j) = w;
                }
                ssq += shx(ssq, lane, 16); ssq = x32_sum(ssq);
                if (g == 0) SSQ[hq * 128 + a + rho] = ssq;
                qf[0] = qn[0]; qf[1] = qn[1];
            }
        }
#undef WIN_PREFETCH
    }

    {
        const int lane = lane_id_opaque();
        const GAS float* cw = (const GAS float*)p.conv_w + layer * 3 * 512 + 8 * lane;
        float w0[8], w1[8], w2[8];
#pragma unroll
        for (int j = 0; j < 8; ++j) { w0[j] = cw[j]; w1[j] = cw[512 + j]; w2[j] = cw[1024 + j]; }
        const int tb = tile0 + 16 * wave;
        u32x4 zr[18];
#pragma unroll
        for (int k = 0; k < 18; ++k) {
            const int t = tb - 1 + k; const bool ok = (t >= s0 && t < s1);
            const u32x4 v = PG(const u32x4, P, (unsigned)(ok ? t : tb) * (unsigned)PW + (unsigned)(C_Z + 8 * lane));
            zr[k] = ok ? v : (u32x4){0u, 0u, 0u, 0u};
        }
        u32x4 cbv[4], gtv[4];
#pragma unroll
        for (int ii = 0; ii < 4; ++ii) { const unsigned ro = (unsigned)(tb + ii) * (unsigned)PW + (unsigned)(8 * lane); cbv[ii] = PG(const u32x4, P, ro + C_CB); gtv[ii] = PG(const u32x4, P, ro + C_GC); }
    __syncthreads();
    if (tid < 128) {
        float s = 0.f;
#pragma unroll
        for (int h = 0; h < 16; ++h) s += SSQ[h * 128 + tid];
        const float ra = rsqrtf(s * (1.0f / 1024.0f) + EPS);
        RAs[tid] = ra;
        ((GAS float*)(wsb + WS_SS))[98304 + tile0 + tid] = ra;
    }
    __syncthreads();
    {
        const int ln = lane_id_opaque();
        const GAS bf16_t* MKV0 = (const GAS bf16_t*)(wsb + WS_MKV) + (size_t)layer * MEMROWS * 1024 + (size_t)ms * 256 * 1024;
        const unsigned ldsb0 = (unsigned)(uintptr_t)lds;
#pragma unroll
        for (int j = 0; j < 8; ++j) {
            const int row = (wave * 8 + j) * 4 + (ln >> 4), pc = ln & 15;
            const int kq = row & 31, kap = (row & ~31) + 8 * ((kq >> 2) & 3) + 4 * (kq >> 4) + (kq & 3);
            glds16((const GAS void*)(MKV0 + (unsigned)kap * 1024u + (unsigned)((pc ^ (row & 15)) * 8)), (unsigned)__builtin_amdgcn_readfirstlane(ldsb0 + L_KM + (wave * 8 + j) * 1024));
        }
#pragma unroll
        for (int j = 0; j < 8; ++j) {
            const int row = (wave * 8 + j) * 4 + (ln >> 4), pc = ln & 15;
            const int fk = ((row & 3) << 1) | (((row >> 3) & 1) << 3);
            glds16((const GAS void*)(MKV0 + (unsigned)row * 1024u + 512u + (unsigned)((pc ^ fk) * 8)), (unsigned)__builtin_amdgcn_readfirstlane(ldsb0 + L_VM + (wave * 8 + j) * 1024));
        }
    }
#pragma unroll
        for (int gi = 0; gi < 4; ++gi) {
            u32x4 cbn[4], gtn[4];
#pragma unroll
            for (int ii = 0; ii < 4; ++ii) { const unsigned ro = (unsigned)(tb + (gi < 3 ? 4 * gi + 4 + ii : ii)) * (unsigned)PW + (unsigned)(8 * lane); cbn[ii] = PG(const u32x4, P, ro + C_CB); gtn[ii] = PG(const u32x4, P, ro + C_GC); }
            float yv[4][8], sq[4];
#pragma unroll
            for (int ii = 0; ii < 4; ++ii) {
                const int i = 4 * gi + ii;
                const u32x4 a = zr[i], c = zr[i + 1], n = zr[i + 2], cbw = cbv[ii];
                const float zp[8] = {bf_lo(a.x), bf_hi(a.x), bf_lo(a.y), bf_hi(a.y), bf_lo(a.z), bf_hi(a.z), bf_lo(a.w), bf_hi(a.w)};
                const float zc[8] = {bf_lo(c.x), bf_hi(c.x), bf_lo(c.y), bf_hi(c.y), bf_lo(c.z), bf_hi(c.z), bf_lo(c.w), bf_hi(c.w)};
                const float zn[8] = {bf_lo(n.x), bf_hi(n.x), bf_lo(n.y), bf_hi(n.y), bf_lo(n.z), bf_hi(n.z), bf_lo(n.w), bf_hi(n.w)};
                const float cb[8] = {bf_lo(cbw.x), bf_hi(cbw.x), bf_lo(cbw.y), bf_hi(cbw.y), bf_lo(cbw.z), bf_hi(cbw.z), bf_lo(cbw.w), bf_hi(cbw.w)};
                float q = 0.f;
#pragma unroll
                for (int j = 0; j < 8; ++j) { yv[ii][j] = cb[j] * (w0[j] * zp[j] + w1[j] * zc[j] + w2[j] * zn[j]); q += yv[ii][j] * yv[ii][j]; }
                sq[ii] = q;
            }
#pragma unroll
            for (int o = 1; o < 64; o <<= 1)
#pragma unroll
                for (int ii = 0; ii < 4; ++ii) sq[ii] += shx(sq[ii], lane, o);
#pragma unroll
            for (int ii = 0; ii < 4; ++ii) {
                const int i = 4 * gi + ii, t = tb + i;
                const u32x4 gtw = gtv[ii];
                const float gt[8] = {bf_lo(gtw.x), bf_hi(gtw.x), bf_lo(gtw.y), bf_hi(gtw.y), bf_lo(gtw.z), bf_hi(gtw.z), bf_lo(gtw.w), bf_hi(gtw.w)};
                const float sc = rsqrtf(sq[ii] * (1.0f / 512.0f) + EPS) * __builtin_amdgcn_rcpf(RAs[16 * wave + i]);
                u32x4 o;
                o.x = cvt_pk_bf16(yv[ii][0] * sc * silu_f(gt[0]), yv[ii][1] * sc * silu_f(gt[1]));
                o.y = cvt_pk_bf16(yv[ii][2] * sc * silu_f(gt[2]), yv[ii][3] * sc * silu_f(gt[3]));
                o.z = cvt_pk_bf16(yv[ii][4] * sc * silu_f(gt[4]), yv[ii][5] * sc * silu_f(gt[5]));
                o.w = cvt_pk_bf16(yv[ii][6] * sc * silu_f(gt[6]), yv[ii][7] * sc * silu_f(gt[7]));
                PG(u32x4, P, (unsigned)t * (unsigned)PW + (unsigned)(C_CB + 8 * lane)) = o;
            }
#pragma unroll
            for (int ii = 0; ii < 4; ++ii) { cbv[ii] = cbn[ii]; gtv[ii] = gtn[ii]; }
        }
    }

    {
        const int lane = lane_id_opaque(), rho = lane & 15, g = lane >> 4;
        const GAS bf16_t* MKV = (const GAS bf16_t*)(wsb + WS_MKV) + (size_t)layer * MEMROWS * 1024 + (size_t)ms * 256 * 1024;
        const int a = 16 * wave, trow = tile0 + a + rho;
        GAS bf16_t* prow = P + (size_t)trow * PW;
        const float scl = 0.08838834764831845f * LOG2E;
        const int fm = ((rho >> 2) << 1) | ((g & 1) << 3);
        const int vlane = (8 * g + (rho >> 2)) * 256;
        unsigned ksrc[8], vsrc[8];
#pragma unroll
        for (int j = 0; j < 8; ++j) {
            const int row = (wave * 8 + j) * 4 + (lane >> 4), pc = lane & 15;
            const int kq = row & 31, kap = (row & ~31) + 8 * ((kq >> 2) & 3) + 4 * (kq >> 4) + (kq & 3);
            ksrc[j] = (unsigned)kap * 1024u + (unsigned)((pc ^ (row & 15)) * 8);
            const int fk = ((row & 3) << 1) | (((row >> 3) & 1) << 3);
            vsrc[j] = (unsigned)row * 1024u + 512u + (unsigned)((pc ^ fk) * 8);
        }
        const unsigned ldsb = (unsigned)(uintptr_t)lds;
#define MEM_DMA_K(H) do { _Pragma("unroll") for (int j = 0; j < 8; ++j) \
            glds16((const GAS void*)(MKV + ksrc[j] + (H) * 128), (unsigned)__builtin_amdgcn_readfirstlane(ldsb + L_KM + (wave * 8 + j) * 1024)); } while (0)
#define MEM_DMA_V(H) do { _Pragma("unroll") for (int j = 0; j < 8; ++j) \
            glds16((const GAS void*)(MKV + vsrc[j] + (H) * 128), (unsigned)__builtin_amdgcn_readfirstlane(ldsb + L_VM + (wave * 8 + j) * 1024)); } while (0)
#define VBAR() do { asm volatile("s_waitcnt vmcnt(0) lgkmcnt(0)" ::: "memory"); __builtin_amdgcn_s_barrier(); asm volatile("" ::: "memory"); } while (0)
        bf16x8 qf[4];
#pragma unroll
        for (int ks = 0; ks < 4; ++ks) qf[ks] = *(const GAS bf16x8*)(prow + C_MQ + 32 * ks + 8 * g);
        float ssq = 0.f;
        u32x4 gtr[16];
#pragma unroll 1
        for (int h = 0; h < 4; ++h) {
            VBAR();
            if (h > 0) MEM_DMA_V(h);
            f32x4 S[8][2];
            {
                LAS unsigned char* kb = lds + L_KM + rho * 256;
                const int kx0 = ((0 + g) ^ rho) << 4, kx1 = ((4 + g) ^ rho) << 4, kx2 = ((8 + g) ^ rho) << 4, kx3 = ((12 + g) ^ rho) << 4;
                bf16x8 kf[2][4];
#define KLD(T, B) do { LAS unsigned char* kp_ = kb + (T) * 4096; kf[B][0] = *(const LAS bf16x8*)(kp_ + kx0); kf[B][1] = *(const LAS bf16x8*)(kp_ + kx1); \
                       kf[B][2] = *(const LAS bf16x8*)(kp_ + kx2); kf[B][3] = *(const LAS bf16x8*)(kp_ + kx3); } while (0)
                KLD(0, 0);
#pragma unroll
                for (int t = 0; t < 16; ++t) {
                    if (t + 1 < 16) KLD(t + 1, (t + 1) & 1);
                    __builtin_amdgcn_sched_barrier(0);
                    f32x4 acc = (f32x4){0.f, 0.f, 0.f, 0.f};
#pragma unroll
                    for (int ks = 0; ks < 4; ++ks) acc = __builtin_amdgcn_mfma_f32_16x16x32_bf16(kf[t & 1][ks], qf[ks], acc, 0, 0, 0);
                    S[t >> 1][t & 1] = acc;
                    __builtin_amdgcn_sched_barrier(0);
                }
#undef KLD
            }
            float mx = -INFINITY;
#pragma unroll
            for (int c = 0; c < 8; ++c)
#pragma unroll
                for (int w = 0; w < 2; ++w) { mx = __builtin_fmaxf(__builtin_fmaxf(mx, S[c][w][0]), S[c][w][1]); mx = __builtin_fmaxf(__builtin_fmaxf(mx, S[c][w][2]), S[c][w][3]); }
            mx = fmaxf(mx, shx(mx, lane, 16)); mx = x32_max(mx);
            const float mb = mx * scl;
#pragma unroll
            for (int c = 0; c < 8; ++c)
#pragma unroll
                for (int w = 0; w < 2; ++w)
#pragma unroll
                    for (int r = 0; r < 4; ++r) S[c][w][r] = __builtin_amdgcn_exp2f(S[c][w][r] * scl - mb);
            f32x4 OS = (f32x4){0.f, 0.f, 0.f, 0.f};
            VBAR();
            if (h < 3) {
                MEM_DMA_K(h + 1);
#pragma unroll
                for (int ks = 0; ks < 4; ++ks) qf[ks] = *(const GAS bf16x8*)(prow + C_MQ + (h + 1) * 128 + 32 * ks + 8 * g);
            } else {
#pragma unroll
                for (int i = 0; i < 8; ++i) gtr[i] = *(const GAS u32x4*)(prow + C_GM + (i >> 2) * 128 + 32 * (i & 3) + 8 * g);
            }
            f32x4 O[8];
#pragma unroll
            for (int dt = 0; dt < 8; ++dt) O[dt] = (f32x4){0.f, 0.f, 0.f, 0.f};
            {
                bf16x8 pf[8];
#pragma unroll
                for (int c = 0; c < 8; ++c) { u32x4 pw; pw.x = cvt_pk_bf16(S[c][0][0], S[c][0][1]); pw.y = cvt_pk_bf16(S[c][0][2], S[c][0][3]); pw.z = cvt_pk_bf16(S[c][1][0], S[c][1][1]); pw.w = cvt_pk_bf16(S[c][1][2], S[c][1][3]);
                    pf[c] = __builtin_bit_cast(bf16x8, pw); }
                LAS unsigned char* vb = lds + L_VM + vlane;
                v4i16_t vlo[2], vhi[2];
#define VLD(I, B) do { const int c_ = (I) >> 3, dt_ = (I) & 7; const int co_ = (((4 * (dt_ >> 1) + (rho & 3)) ^ fm) << 4) + 8 * (dt_ & 1); vlo[B] = tr16(vb + c_ * 8192 + co_); vhi[B] = tr16(vb + c_ * 8192 + 1024 + co_); } while (0)
                VLD(0, 0);
#pragma unroll
                for (int i = 0; i < 64; ++i) {
                    if (i + 1 < 64) VLD(i + 1, (i + 1) & 1);
                    if ((i & 7) == 0) OS = __builtin_amdgcn_mfma_f32_16x16x32_bf16(ONES8, pf[i >> 3], OS, 0, 0, 0);
                    __builtin_amdgcn_sched_barrier(0);
                    const bf16x8 vf = (bf16x8){vlo[i & 1][0], vlo[i & 1][1], vlo[i & 1][2], vlo[i & 1][3], vhi[i & 1][0], vhi[i & 1][1], vhi[i & 1][2], vhi[i & 1][3]};
                    O[i & 7] = __builtin_amdgcn_mfma_f32_16x16x32_bf16(vf, pf[i >> 3], O[i & 7], 0, 0, 0);
                    __builtin_amdgcn_sched_barrier(0);
                }
#undef VLD
            }
            const float il = __builtin_amdgcn_rcpf(OS[0]);
#pragma unroll
            for (int j = 0; j < 4; ++j) {
                const f32x4 o0 = O[2 * j] * il, o1 = O[2 * j + 1] * il;
                ssq += (o0[0] * o0[0] + o0[1] * o0[1]) + (o0[2] * o0[2] + o0[3] * o0[3]) + (o1[0] * o1[0] + o1[1] * o1[1]) + (o1[2] * o1[2] + o1[3] * o1[3]);
                u32x4 w; w.x = cvt_pk_bf16(o0[0], o0[1]); w.y = cvt_pk_bf16(o0[2], o0[3]); w.z = cvt_pk_bf16(o1[0], o1[1]); w.w = cvt_pk_bf16(o1[2], o1[3]);
                *(GAS u32x4*)(prow + C_MQ + h * 128 + 32 * j + 8 * g) = w;
            }
        }
#undef MEM_DMA_K
#undef MEM_DMA_V
        ssq += shx(ssq, lane, 16); ssq = x32_sum(ssq);
        const float sc = rsqrtf(ssq * (1.0f / 512.0f) + EPS) * __builtin_amdgcn_rcpf(RAs[a + rho]);
        u32x4 ovr[16];
#pragma unroll
        for (int i = 0; i < 16; ++i) { const int col = (i >> 2) * 128 + 32 * (i & 3) + 8 * g; ovr[i] = *(const GAS u32x4*)(prow + C_MQ + col); if (i >= 8) gtr[i] = *(const GAS u32x4*)(prow + C_GM + col); }
#pragma unroll
        for (int h = 0; h < 4; ++h) {
#pragma unroll
            for (int j = 0; j < 4; ++j) {
                const int col = h * 128 + 32 * j + 8 * g;
                const u32x4 ov = ovr[4 * h + j], gt = gtr[4 * h + j];
                u32x4 w;
                w.x = cvt_pk_bf16(bf_lo(ov.x) * sc * silu_f(bf_lo(gt.x)), bf_hi(ov.x) * sc * silu_f(bf_hi(gt.x)));
                w.y = cvt_pk_bf16(bf_lo(ov.y) * sc * silu_f(bf_lo(gt.y)), bf_hi(ov.y) * sc * silu_f(bf_hi(gt.y)));
                w.z = cvt_pk_bf16(bf_lo(ov.z) * sc * silu_f(bf_lo(gt.z)), bf_hi(ov.z) * sc * silu_f(bf_hi(gt.z)));
                w.w = cvt_pk_bf16(bf_lo(ov.w) * sc * silu_f(bf_lo(gt.w)), bf_hi(ov.w) * sc * silu_f(bf_hi(gt.w)));
                *(GAS u32x4*)(prow + C_MQ + col) = w;
            }
        }
    }
    VBAR();
    __builtin_amdgcn_s_setprio(0);
#undef VBAR
}

#define XB_TMO      128
#define XB_XCNT(j)  (256  + 64 * (j))
#define XB_XSUB(j)  (1280 + 64 * (j))
#define XB_XGEN(j)  (2304 + 64 * (j))
#define XB_TOP      3328
#define XB_TOPGEN   3392
#define XCD_BAR_WORDS 3456
#define XB_SPIN_CAP (1u << 18)

__device__ __forceinline__ unsigned xb_ld(unsigned* p)              { return __hip_atomic_load(p, __ATOMIC_RELAXED, __HIP_MEMORY_SCOPE_AGENT); }
__device__ __forceinline__ unsigned xb_add(unsigned* p, unsigned v) { return __hip_atomic_fetch_add(p, v, __ATOMIC_RELAXED, __HIP_MEMORY_SCOPE_AGENT); }
__device__ __forceinline__ unsigned xb_xcc_id() { return (unsigned)__builtin_amdgcn_s_getreg((3 << 11) | 20) & 0xFu; }
#define XB_SPIN(cond, bar) do { unsigned _sp = 0; while (cond) { __builtin_amdgcn_s_sleep(1); \
    if ((++_sp & 255u) == 0u) { if (xb_ld(&(bar)[XB_TMO])) break; if (_sp > XB_SPIN_CAP) { atomicAdd(&(bar)[XB_TMO], 1u); break; } } } } while (0)

struct XcdBarrier {
    unsigned* bar; unsigned x;
    volatile LAS unsigned* st;
};

__device__ __forceinline__ XcdBarrier xcd_barrier_post(unsigned* bar, volatile LAS unsigned* st) {
    XcdBarrier b; b.bar = bar; b.x = xb_xcc_id(); b.st = st;
    if (threadIdx.x == 0) (void)xb_add(&bar[XB_XCNT(b.x)], 1u);
    return b;
}
__device__ __forceinline__ void xcd_barrier_complete(unsigned* bar, unsigned x, unsigned& nloc, unsigned& nx) {
    const unsigned G = gridDim.x * gridDim.y * gridDim.z;
    unsigned sum, cnt, mine, sp = 0u;
    for (;;) {
        sum = 0u; cnt = 0u; mine = 0u;
#pragma unroll
        for (unsigned j = 0; j < 16; ++j) { const unsigned c = xb_ld(&bar[XB_XCNT(j)]); sum += c; cnt += (c > 0u) ? 1u : 0u; mine = (j == x) ? c : mine; }
        if (sum == G) break;
        __builtin_amdgcn_s_sleep(1);
        if ((++sp & 255u) == 0u) { if (xb_ld(&bar[XB_TMO])) break; if (sp > XB_SPIN_CAP) { atomicAdd(&bar[XB_TMO], 1u); break; } }
    }
    nloc = mine > 0u ? mine : 1u; nx = cnt > 0u ? cnt : 1u;
}

__device__ __forceinline__ void xcd_barrier(const XcdBarrier& b, bool leader) {
    asm volatile("s_waitcnt vmcnt(0)" ::: "memory");
    __syncthreads();
    if (leader) {
        unsigned* bar = b.bar; unsigned bx_ = b.x; asm volatile("" : "+s"(bar), "+s"(bx_));
        __builtin_amdgcn_s_waitcnt(0);
        unsigned nloc = b.st[0], nx = b.st[1];
        if (nloc == 0u) { xcd_barrier_complete(bar, bx_, nloc, nx); b.st[0] = nloc; b.st[1] = nx; }
        const unsigned old = xb_add(&bar[XB_XSUB(bx_)], 1u);
        const unsigned gen = old / nloc;
        if (old + 1u == (gen + 1u) * nloc) {
            __builtin_amdgcn_fence(__ATOMIC_RELEASE, "agent");
            asm volatile("s_waitcnt vmcnt(0)" ::: "memory");
            const unsigned og = xb_add(&bar[XB_TOP], 1u);
            const unsigned tg = og / nx;
            if (og + 1u == (tg + 1u) * nx) xb_add(&bar[XB_TOPGEN], 1u);
            else XB_SPIN(xb_ld(&bar[XB_TOPGEN]) == tg, bar);
            __builtin_amdgcn_fence(__ATOMIC_ACQUIRE, "agent");
            xb_add(&bar[XB_XGEN(bx_)], 1u);
            asm volatile("s_waitcnt vmcnt(0)" ::: "memory");
        } else {
            XB_SPIN(xb_ld(&bar[XB_XGEN(bx_)]) == gen, bar);
            __builtin_amdgcn_fence(__ATOMIC_ACQUIRE, "agent");
            asm volatile("s_waitcnt vmcnt(0)" ::: "memory");
        }
    }
    __syncthreads();
}

__global__ void __launch_bounds__(NTHREADS, 2) __attribute__((amdgpu_waves_per_eu(2, 2))) hymba_fwd(Params p) {
    extern __shared__ __attribute__((aligned(16))) unsigned char lds_raw[];
    LAS unsigned char* lds = (LAS unsigned char*)lds_raw;
    cg::grid_group grid = cg::this_grid();
    const int G = gridDim.x, bx = blockIdx.x;
    const int wave_s = __builtin_amdgcn_readfirstlane(threadIdx.x >> 6);
    const int vcu = (G % 8 == 0) ? (bx % 8) * (G / 8) + bx / 8 : bx;
    unsigned char* ws = p.ws; unsigned char* dob = (unsigned char*)p.out;
    bf16_t* P = (bf16_t*)(ws + WS_P); bf16_t* XN = (bf16_t*)(ws + WS_XN);
    float* SS0 = (float*)(ws + WS_SS); float* SS1 = SS0 + 32768; float* SSF = SS0 + 65536; float* RA = SS0 + 98304;
    const f32x2* rope = (const f32x2*)(ws + WS_ROPE);

#ifndef NO_P0
    if (threadIdx.x == 0) { ((LAS unsigned*)(lds + L_MISC))[0] = 0u; ((LAS unsigned*)(lds + L_MISC))[1] = 0u; }
    __syncthreads();
    XcdBarrier xbar = xcd_barrier_post((unsigned*)(ws + WS_CTL), (volatile LAS unsigned*)(lds + L_MISC));
    if (G == 0x7fffffff) grid.sync();
    constexpr int NMEMCU = 24;
    p0_prologue(p, lds, bx, G, 0, 0);
    xcd_barrier(xbar, wave_s == 0 && lane_id_opaque() == 0);
    if (bx < NMEMCU) {
        const int l = bx / 12;
        pg8::Gemm g2{(const bf16_t*)(dob + DO_MEMN) + (size_t)l * MEMROWS * 2048, (const bf16_t*)(dob + DO_WMKV) + (size_t)l * 1024 * 2048, MEMROWS, 1024, DM, DM};
        pg8::StaticOrder S2; S2.init(MEMROWS, 1024, G, bx % 12);
        pg8::EpiPlain E2{(bf16_t*)(ws + WS_MKV) + (size_t)l * MEMROWS * 1024, 1024, nullptr};
        pg8::gemm_phase<pg8::EpiPlain, pg8::StaticOrder, true>(lds, g2, S2, E2, wave_s);
    }
    p0_prologue(p, lds, bx, G, NMEMCU, 1);
#endif
    xcd_barrier(xbar, wave_s == 0 && lane_id_opaque() == 0);

#pragma unroll 1
    for (int layer = 0; layer < 2; ++layer) {
        asm volatile("" : "+s"(ws), "+s"(dob));
        P = (bf16_t*)(ws + WS_P); XN = (bf16_t*)(ws + WS_XN); SS0 = (float*)(ws + WS_SS); SS1 = SS0 + 32768; SSF = SS0 + 65536; RA = SS0 + 98304; rope = (const f32x2*)(ws + WS_ROPE);
        float* outp = (float*)dob;
        {
            const bf16_t* Wt = layer == 0 ? (const bf16_t*)(dob + DO_WIN0) : (const bf16_t*)(ws + WS_WIN1);
            pg8::Gemm gm{XN, Wt, T_TOK, NIN, DM, DM};
            pg8::StaticOrder S; S.init(T_TOK, NIN, G, bx);
            pg8::EpiIn E{P, layer == 0 ? SS0 : SS1, rope};
#ifndef NO_G1
            pg8::gemm_phase<pg8::EpiIn, pg8::StaticOrder, true>(lds, gm, S, E, wave_s);
#endif
        }
        xcd_barrier(xbar, wave_s == 0 && lane_id_opaque() == 0);
#ifndef NO_MIXER
        for (int tile = vcu; tile < T_TOK / 128; tile += G) mixer_unit(p, lds, tile, layer, wave_s);
#endif
        xcd_barrier(xbar, wave_s == 0 && lane_id_opaque() == 0);
        {
            pg8::Gemm gm{P, (const bf16_t*)(ws + WS_WOUT) + (size_t)layer * 2048 * 2048, T_TOK, DM, DM, PW};
            pg8::StaticOrder S; S.init(T_TOK, DM, G, bx);
            pg8::EpiOut E;
            E.x0a = p.x_prompt; E.x0b = p.x_sample; E.mode = layer; E.XN = XN; E.rowtab = RA; E.SSn = layer == 0 ? SS1 : SSF;
#ifndef NO_G3
            pg8::gemm_phase<pg8::EpiOut, pg8::StaticOrder, true>(lds, gm, S, E, wave_s);
#endif
        }
        xcd_barrier(xbar, wave_s == 0 && lane_id_opaque() == 0);
    }
    {
        int tidf = wave_s * 64 + lane_id_opaque(); asm volatile("" : "+v"(tidf));
        const int tid = tidf, lane = tid & 63, wave = tid >> 6;
        const int gw = vcu * 8 + wave, NGW = G * 8;
        f32x4 gf[4][2];
#pragma unroll
        for (int j = 0; j < 4; ++j) { gf[j][0] = ((const GAS f32x4*)p.final_norm)[2 * (lane + 64 * j)]; gf[j][1] = ((const GAS f32x4*)p.final_norm)[2 * (lane + 64 * j) + 1]; }
        for (int row = gw; row < T_TOK; row += NGW) {
            const GAS u32x4* yr = (const GAS u32x4*)((const GAS bf16_t*)(ws + WS_XN) + (size_t)row * 2048);
            GAS f32x4* orow = (GAS f32x4*)((GAS float*)p.out + (size_t)row * 2048);
            const float rs = rsqrtf(((const GAS float*)SSF)[row] * (1.0f / 2048.0f) + EPS);
#pragma unroll
            for (int j = 0; j < 4; ++j) {
                const u32x4 w = yr[lane + 64 * j];
                orow[2 * (lane + 64 * j)] = (f32x4){bf_lo(w.x), bf_hi(w.x), bf_lo(w.y), bf_hi(w.y)} * rs * gf[j][0];
                orow[2 * (lane + 64 * j) + 1] = (f32x4){bf_lo(w.z), bf_hi(w.z), bf_lo(w.w), bf_hi(w.w)} * rs * gf[j][1];
            }
        }
    }
}

extern "C" void kernel_launch(void* const* d_in, const int* in_sizes, int n_in, void* d_out, int out_size, void* d_ws, size_t ws_size, hipStream_t stream) {
    static int grid = 0;
    if (grid == 0) {
        int dev = 0, cus = 0, per_cu = 0;
        hipGetDevice(&dev);
        hipDeviceGetAttribute(&cus, hipDeviceAttributeMultiprocessorCount, dev);
        hipFuncSetAttribute((const void*)hymba_fwd, hipFuncAttributeMaxDynamicSharedMemorySize, LDS_BYTES);
        hipOccupancyMaxActiveBlocksPerMultiprocessor(&per_cu, (const void*)hymba_fwd, NTHREADS, LDS_BYTES);
        if (per_cu < 1) { fprintf(stderr, "kernel_launch: occupancy query says %d blocks/CU\n", per_cu); per_cu = 1; }
        grid = cus;
        if (ws_size < WS_END) fprintf(stderr, "kernel_launch: workspace too small: %zu < %zu\n", ws_size, (size_t)WS_END);
        (void)hipGetLastError();
    }
    Params p{};
    p.x_prompt = (const float*)d_in[0]; p.x_sample = (const float*)d_in[1]; p.mem_prompt = (const float*)d_in[2]; p.mem_sample = (const float*)d_in[3];
    p.norm_in = (const float*)d_in[4]; p.w_in = (const float*)d_in[5]; p.sink = (const float*)d_in[6]; p.conv_w = (const float*)d_in[7];
    p.norm_mem = (const float*)d_in[8]; p.w_mem_kv = (const float*)d_in[9]; p.g_attn = (const float*)d_in[10]; p.g_conv = (const float*)d_in[11];
    p.g_mem = (const float*)d_in[12]; p.w_out = (const float*)d_in[13]; p.final_norm = (const float*)d_in[14];
    p.out = (float*)d_out; p.ws = (unsigned char*)d_ws;
    (void)hipMemsetAsync((unsigned char*)d_ws + WS_CTL, 0, CTL_BYTES, stream);
    void* args[] = {&p};
    hipError_t e = hipLaunchCooperativeKernel((const void*)hymba_fwd, dim3(grid), dim3(NTHREADS), args, LDS_BYTES, stream);
    if (e != hipSuccess) fprintf(stderr, "cooperative launch failed: %s (grid %d)\n", hipGetErrorString(e), grid);
}
```

```cpp
#include <hip/hip_runtime.h>
#include <hip/hip_cooperative_groups.h>
#include <cstdio>
#include <cstdint>
namespace cg = cooperative_groups;

#define LAS __attribute__((address_space(3)))
#define GAS __attribute__((address_space(1)))
typedef unsigned short bf16_t;
typedef short bf16x8 __attribute__((ext_vector_type(8)));
typedef float f32x4 __attribute__((ext_vector_type(4)));
typedef float f32x2 __attribute__((ext_vector_type(2)));
typedef unsigned u32x4 __attribute__((ext_vector_type(4)));
typedef unsigned u32x2 __attribute__((ext_vector_type(2)));

constexpr int T_TOK = 32768, DM = 2048, NIN = 5632, PW = 5120, NMEM = 256, MEMROWS = 768;
constexpr float EPS = 1e-6f, LOG2E = 1.4426950408889634f;
constexpr int C_Q = 0, C_CB = 1024, C_MQ = 1536, C_K = 2048, C_V = 2304, C_GA = 2560, C_GC = 3584, C_GM = 4096, C_Z = 4608;

__device__ __forceinline__ unsigned cvt_pk_bf16(float lo, float hi) { unsigned r; asm volatile("v_cvt_pk_bf16_f32 %0, %1, %2" : "=v"(r) : "v"(lo), "v"(hi)); return r; }
__device__ __forceinline__ float bf_lo(unsigned w) { return __uint_as_float(w << 16); }
__device__ __forceinline__ float bf_hi(unsigned w) { return __uint_as_float(w & 0xffff0000u); }
__device__ __forceinline__ int lane_id_opaque() { int l; asm volatile("v_mbcnt_lo_u32_b32 %0, -1, 0\n\tv_mbcnt_hi_u32_b32 %0, -1, %0" : "=&v"(l)); return l; }
__device__ __forceinline__ float shx(float v, int lane, int mask) { return __int_as_float(__builtin_amdgcn_ds_bpermute((lane ^ mask) << 2, __float_as_int(v))); }
__device__ __forceinline__ float x32_max(float v) { auto rr = __builtin_amdgcn_permlane32_swap(__float_as_uint(v), __float_as_uint(v), false, false); return fmaxf(__uint_as_float(rr[0]), __uint_as_float(rr[1])); }
__device__ __forceinline__ float x32_sum(float v) { auto rr = __builtin_amdgcn_permlane32_swap(__float_as_uint(v), __float_as_uint(v), false, false); return __uint_as_float(rr[0]) + __uint_as_float(rr[1]); }
__device__ __forceinline__ float silu_f(float x) { return x * __builtin_amdgcn_rcpf(1.0f + __builtin_amdgcn_exp2f(-x * LOG2E)); }

namespace pg8 {
#define PG8_LAS __attribute__((address_space(3)))
typedef unsigned short bf16_t;
typedef short bf16x8 __attribute__((ext_vector_type(8)));
typedef float f32x4 __attribute__((ext_vector_type(4)));
typedef unsigned u32x4 __attribute__((ext_vector_type(4)));
constexpr int BM = 256, BK = 64, HALF = 128, HTB = HALF * BK * 2  , STAGE_BYTES = 8 * HTB, NXCD = 8, WGM = 4;
constexpr int ROWTAB_OFF = STAGE_BYTES;

__host__ __device__ __forceinline__ int lds_byte(int r, int c) { const int st = (r >> 4) * 2 + (c >> 5), rr = r & 15, cc = c & 31, ob = rr * 64 + cc * 2; return st * 1024 + (ob ^ (((ob >> 9) & 1) << 5)); }
__host__ __device__ __forceinline__ void stage_rc(int b, int& R, int& C) { const int st = b / 1024, sb = b % 1024, swz = sb ^ (((sb >> 9) & 1) << 5); R = (st >> 1) * 16 + swz / 64; C = (st & 1) * 32 + (swz % 64) / 2; }
__host__ __device__ __forceinline__ int perm32(int rho) { const int n = rho >> 4, i = rho & 15; return 8 * (i >> 2) + 4 * n + (i & 3); }

struct Unit { int pm, pn; };
struct Gemm { const bf16_t* A; const bf16_t* Bt; int M, N, K, lda; };

struct StaticOrder {
    int nM, nN, nwg, G, c;
    __host__ __device__ void init(int M, int N, int G_, int c_) { nM = M / BM; nN = N / BM; nwg = nM * nN; G = G_; c = c_; }
    __host__ __device__ bool next(int i, Unit& u) const {
        const long L = (long)i * G + c; if (L >= nwg) return false;
        int wgid = (int)L; { const int q = nwg / NXCD, r = nwg % NXCD, xcd = wgid % NXCD, off = wgid / NXCD; wgid = (xcd < r ? xcd * (q + 1) : r * (q + 1) + (xcd - r) * q) + off; }
        const int nig = WGM * nN, gid = wgid / nig, fm = gid * WGM, gsz = (nM - fm) < WGM ? (nM - fm) : WGM;
        u.pm = fm + ((wgid % nig) % gsz); u.pn = (wgid % nig) / gsz; return true;
    }
    __device__ __forceinline__ void a_ready(const Unit&) const {}
    __device__ __forceinline__ void done(const Unit&) const {}
};

struct EpiIn {
    static constexpr bool PERM = true, AFTER_DRAIN = false;
    static constexpr bool ROWTAB = true;
    bf16_t* P; const float* rowtab; const f32x2* rope;
    __device__ __forceinline__ void operator()(const f32x4 (&acc)[2][2][4][2], const Unit& u, int wr, int wc, int fr, int fq, const PG8_LAS float* tab) const {
        const int pn = u.pn; const bool is_rope = (pn < 4) || (pn == 8); const bool is_z = (pn >= 18); const float qs = (pn < 4) ? 0.125f : 1.0f;
#pragma unroll
        for (int ai = 0; ai < 2; ++ai)
#pragma unroll
            for (int m = 0; m < 4; ++m) {
                const int row = u.pm * BM + ai * HALF + wr * 64 + m * 16 + fr;
                const float rs = rsqrtf(tab[ai * HALF + wr * 64 + m * 16 + fr] * (1.0f / 2048.0f) + 1e-6f);
                const int pos = row < 16384 ? (row & 8191) : (row - 16384);
                GAS bf16_t* rowp = (GAS bf16_t*)P + (size_t)row * 5120;
                if (is_z) {
                    const f32x4 z0 = (acc[ai][0][m][0] * rs) * (acc[ai][1][m][0] * rs), z1 = (acc[ai][0][m][1] * rs) * (acc[ai][1][m][1] * rs);
                    u32x4 w; w.x = cvt_pk_bf16(z0[0], z0[1]); w.y = cvt_pk_bf16(z0[2], z0[3]); w.z = cvt_pk_bf16(z1[0], z1[1]); w.w = cvt_pk_bf16(z1[2], z1[3]);
                    *(GAS u32x4*)(rowp + 4608 + (pn - 18) * 128 + wc * 32 + 8 * fq) = w;
                    continue;
                }
#pragma unroll
                for (int bj = 0; bj < 2; ++bj) {
                    const int col0 = pn * BM + bj * HALF + wc * 32 + 8 * fq;
                    f32x4 v0 = acc[ai][bj][m][0] * rs, v1 = acc[ai][bj][m][1] * rs;
                    if (is_rope) {
                        const GAS f32x4* rp = (const GAS f32x4*)((const GAS f32x2*)rope + (size_t)pos * 32 + ((col0 & 63) >> 1));
                        const f32x4 cs0 = rp[0], cs1 = rp[1];
                        f32x4 o0, o1;
                        o0[0] = v0[0] * cs0[0] - v0[1] * cs0[1]; o0[1] = v0[1] * cs0[0] + v0[0] * cs0[1];
                        o0[2] = v0[2] * cs0[2] - v0[3] * cs0[3]; o0[3] = v0[3] * cs0[2] + v0[2] * cs0[3];
                        o1[0] = v1[0] * cs1[0] - v1[1] * cs1[1]; o1[1] = v1[1] * cs1[0] + v1[0] * cs1[1];
                        o1[2] = v1[2] * cs1[2] - v1[3] * cs1[3]; o1[3] = v1[3] * cs1[2] + v1[2] * cs1[3];
                        v0 = o0 * qs; v1 = o1 * qs;
                    }
                    {
                        u32x4 w; w.x = cvt_pk_bf16(v0[0], v0[1]); w.y = cvt_pk_bf16(v0[2], v0[3]); w.z = cvt_pk_bf16(v1[0], v1[1]); w.w = cvt_pk_bf16(v1[2], v1[3]);
                        *(GAS u32x4*)(rowp + col0) = w;
                    }
                }
            }
    }
};
struct EpiPlain {
    static constexpr bool PERM = true, AFTER_DRAIN = false;
    static constexpr bool ROWTAB = false;
    bf16_t* O; int ldc; const float* rowtab;
    __device__ __forceinline__ void operator()(const f32x4 (&acc)[2][2][4][2], const Unit& u, int wr, int wc, int fr, int fq, const PG8_LAS float*) const {
#pragma unroll
        for (int ai = 0; ai < 2; ++ai)
#pragma unroll
            for (int m = 0; m < 4; ++m) {
                const int row = u.pm * BM + ai * HALF + wr * 64 + m * 16 + fr;
#pragma unroll
                for (int bj = 0; bj < 2; ++bj) {
                    const int col0 = u.pn * BM + bj * HALF + wc * 32 + 8 * fq;
                    const f32x4 v0 = acc[ai][bj][m][0], v1 = acc[ai][bj][m][1];
                    u32x4 w; w.x = cvt_pk_bf16(v0[0], v0[1]); w.y = cvt_pk_bf16(v0[2], v0[3]); w.z = cvt_pk_bf16(v1[0], v1[1]); w.w = cvt_pk_bf16(v1[2], v1[3]);
                    *(GAS u32x4*)((GAS bf16_t*)O + (size_t)row * ldc + col0) = w;
                }
            }
    }
};
struct EpiOut {
    static constexpr bool PERM = true, AFTER_DRAIN = false, ROWTAB = true;
    const float* x0a; const float* x0b; int mode; bf16_t* XN; const float* rowtab; float* SSn;
    __device__ __forceinline__ void operator()(const f32x4 (&acc)[2][2][4][2], const Unit& u, int wr, int wc, int fr, int fq, const PG8_LAS float* tab) const {
#pragma unroll
        for (int ai = 0; ai < 2; ++ai)
#pragma unroll
            for (int m = 0; m < 4; ++m) {
                const int row = u.pm * BM + ai * HALF + wr * 64 + m * 16 + fr;
                const float ra = tab[ai * HALF + wr * 64 + m * 16 + fr];
                const GAS float* xo = (const GAS float*)(row < 16384 ? x0a + (size_t)row * 2048 : x0b + (size_t)(row - 16384) * 2048);
                GAS bf16_t* xr = (GAS bf16_t*)XN + (size_t)row * 2048;
                float ssq = 0.f;
#pragma unroll
                for (int bj = 0; bj < 2; ++bj) {
                    const int col0 = u.pn * BM + bj * HALF + wc * 32 + 8 * fq;
                    f32x4 a0, a1;
                    if (mode == 0) { a0 = *(const GAS f32x4*)(xo + col0); a1 = *(const GAS f32x4*)(xo + col0 + 4); }
                    else { const u32x4 w = *(const GAS u32x4*)(xr + col0);
                        a0 = (f32x4){bf_lo(w.x), bf_hi(w.x), bf_lo(w.y), bf_hi(w.y)}; a1 = (f32x4){bf_lo(w.z), bf_hi(w.z), bf_lo(w.w), bf_hi(w.w)}; }
                    const f32x4 v0 = a0 + acc[ai][bj][m][0] * ra, v1 = a1 + acc[ai][bj][m][1] * ra;
                    ssq += (v0[0] * v0[0] + v0[1] * v0[1]) + (v0[2] * v0[2] + v0[3] * v0[3]) + (v1[0] * v1[0] + v1[1] * v1[1]) + (v1[2] * v1[2] + v1[3] * v1[3]);
                    u32x4 w; w.x = cvt_pk_bf16(v0[0], v0[1]); w.y = cvt_pk_bf16(v0[2], v0[3]); w.z = cvt_pk_bf16(v1[0], v1[1]); w.w = cvt_pk_bf16(v1[2], v1[3]);
                    *(GAS u32x4*)(xr + col0) = w;
                }
                { const int ln = fr + 16 * fq; ssq += shx(ssq, ln, 16); ssq = x32_sum(ssq); }
                if (fq == 0) unsafeAtomicAdd(SSn + row, ssq);
            }
    }
};

template <class Epi, class Sched, bool ALIGN_EPI = false, bool SP2 = true>
__device__ __forceinline__ void gemm_phase(PG8_LAS unsigned char* lds, const Gemm g, const Sched& S, const Epi& E, int wave_s) {
    int tid_ = wave_s * 64 + lane_id_opaque(); asm volatile("" : "+v"(tid_));
    const int tid = tid_, wid = __builtin_amdgcn_readfirstlane(tid >> 6), lane = tid & 63, wr = wid >> 2, wc = wid & 3, fr = lane & 15, fq = lane >> 4;
    const int K = g.K, nt = K / BK, lda = g.lda;
    unsigned voffA[2], voffB[2];
#pragma unroll
    for (int i = 0; i < 2; ++i) { int R, C; stage_rc(tid * 16 + i * 8192, R, C); const int Rb = Epi::PERM ? ((R & ~31) + perm32(R & 31)) : R;
        voffA[i] = (unsigned)(R * lda + C) * 2u; voffB[i] = (unsigned)(Rb * K + C) * 2u; }
    const size_t kstep = (size_t)(BK * 2);
    const size_t hstepA = (size_t)HALF * lda * 2, hstepB = (size_t)HALF * K * 2;
    const size_t tstepA = 2 * hstepA, tstepB = 2 * hstepB;
    const unsigned ldsw = (unsigned)wid * 1024u;
    const int aoff = lds_byte(wr * 64 + fr, fq * 8), boff = lds_byte(wc * 32 + fr, fq * 8);
#define PG8_SA(b, h) (((b) * 2 + (h)) * HTB)
#define PG8_SB(b, h) ((4 + (b) * 2 + (h)) * HTB)
#define PG8_STAGE(bufoff, gbase, voff) do { _Pragma("unroll") for (int _i = 0; _i < 2; ++_i) \
        __builtin_amdgcn_global_load_lds((const unsigned*)((const char*)(gbase) + (voff)[_i]), (PG8_LAS unsigned*)(lds + (bufoff) + ldsw + _i * 8192), 16, 0, 0); } while (0)
#define PG8_LDA(dst, b, h) do { _Pragma("unroll") for (int m = 0; m < 4; ++m) _Pragma("unroll") for (int k = 0; k < 2; ++k) dst[m][k] = *(const PG8_LAS bf16x8*)(lds + PG8_SA(b, h) + aoff + m * 2048 + k * 1024); } while (0)
#define PG8_LDB(dst, b, h) do { _Pragma("unroll") for (int n = 0; n < 2; ++n) _Pragma("unroll") for (int k = 0; k < 2; ++k) dst[n][k] = *(const PG8_LAS bf16x8*)(lds + PG8_SB(b, h) + boff + n * 2048 + k * 1024); } while (0)
#define PG8_MMA(ai, bj, At, Bt) do { __builtin_amdgcn_s_setprio(1); _Pragma("unroll") for (int m = 0; m < 4; ++m) _Pragma("unroll") for (int n = 0; n < 2; ++n) _Pragma("unroll") for (int k = 0; k < 2; ++k) \
        acc[ai][bj][m][n] = __builtin_amdgcn_mfma_f32_16x16x32_bf16(Bt[n][k], At[m][k], acc[ai][bj][m][n], 0, 0, 0); __builtin_amdgcn_s_setprio(0); } while (0)
#define PG8_WAIT_V(n) asm volatile("s_waitcnt vmcnt(" #n ")" ::: "memory")
#define PG8_WAIT_L(n) asm volatile("s_waitcnt lgkmcnt(" #n ")" ::: "memory")
#define PG8_BAR __builtin_amdgcn_s_barrier()
#define PG8_SCHED __builtin_amdgcn_sched_barrier(0)
    Unit cur, nxt; int ui = 0;
    if (!S.next(0, cur)) return;
    f32x4 acc[2][2][4][2];
#pragma unroll
    for (int a = 0; a < 2; ++a)
#pragma unroll
        for (int b = 0; b < 2; ++b)
#pragma unroll
            for (int m = 0; m < 4; ++m)
#pragma unroll
                for (int n = 0; n < 2; ++n) acc[a][b][m][n] = (f32x4){0.f, 0.f, 0.f, 0.f};
    bf16x8 At[4][2], B0[2][2], B1[2][2];
    const char* cA = (const char*)g.A + (size_t)cur.pm * tstepA; const char* cB = (const char*)g.Bt + (size_t)cur.pn * tstepB;
    S.a_ready(cur);
    if constexpr (SP2) {
        PG8_STAGE(PG8_SB(0, 0), cB, voffB); PG8_STAGE(PG8_SB(0, 1), cB + hstepB, voffB); PG8_STAGE(PG8_SA(0, 0), cA, voffA); PG8_STAGE(PG8_SA(0, 1), cA + hstepA, voffA);
        if (wr == 1) PG8_BAR;
        PG8_WAIT_V(2); PG8_BAR;
        PG8_STAGE(PG8_SB(1, 0), cB + kstep, voffB); PG8_STAGE(PG8_SA(1, 0), cA + kstep, voffA); PG8_STAGE(PG8_SB(1, 1), cB + hstepB + kstep, voffB);
        PG8_WAIT_V(6); PG8_BAR;
    } else {
        PG8_STAGE(PG8_SB(0, 0), cB, voffB); PG8_STAGE(PG8_SA(0, 0), cA, voffA); PG8_STAGE(PG8_SB(0, 1), cB + hstepB, voffB); PG8_STAGE(PG8_SA(0, 1), cA + hstepA, voffA);
        if (wr == 1) PG8_BAR;
        PG8_WAIT_V(4); PG8_BAR;
        PG8_STAGE(PG8_SB(1, 0), cB + kstep, voffB); PG8_STAGE(PG8_SA(1, 0), cA + kstep, voffA); PG8_STAGE(PG8_SB(1, 1), cB + hstepB + kstep, voffB);
        PG8_WAIT_V(6); PG8_BAR;
    }
    for (;;) {
        const bool has_next = S.next(ui + 1, nxt);
        const char* nA = has_next ? (const char*)g.A + (size_t)nxt.pm * tstepA : cA; const char* nB = has_next ? (const char*)g.Bt + (size_t)nxt.pn * tstepB : cB;
        if (Epi::ROWTAB && wid < 4)
            __builtin_amdgcn_global_load_lds((const GAS unsigned*)((const GAS char*)(E.rowtab + cur.pm * BM + wid * 64) + (size_t)(unsigned)(lane_id_opaque() * 4)), (PG8_LAS unsigned*)(lds + ROWTAB_OFF + (ui & 1) * 1024 + wid * 256), 4, 0, 0);
        for (int t = 0; t < nt; t += 2) {
            const bool last = (t == nt - 2);
            const char* a1 = cA + (size_t)(t + 1) * kstep;
            const char* a2 = last ? nA : cA + (size_t)(t + 2) * kstep; const char* b2 = last ? nB : cB + (size_t)(t + 2) * kstep;
            const char* a3 = a2 + kstep; const char* b3 = b2 + kstep;
            if (last && has_next) S.a_ready(nxt);
            if constexpr (SP2) {
            PG8_LDB(B0, 0, 0); PG8_LDB(B1, 0, 1); PG8_SCHED; PG8_LDA(At, 0, 0); PG8_STAGE(PG8_SA(1, 1), a1 + hstepA, voffA);
            PG8_WAIT_V(8); PG8_WAIT_L(0); PG8_BAR; PG8_MMA(0, 0, At, B0); PG8_MMA(0, 1, At, B1); PG8_BAR; PG8_SCHED;
            PG8_LDA(At, 0, 1); PG8_STAGE(PG8_SB(0, 0), b2, voffB); PG8_STAGE(PG8_SB(0, 1), b2 + hstepB, voffB); PG8_STAGE(PG8_SA(0, 0), a2, voffA);
            PG8_WAIT_V(8); PG8_WAIT_L(0); PG8_BAR; PG8_MMA(1, 0, At, B0); PG8_MMA(1, 1, At, B1); PG8_BAR; PG8_SCHED;
            PG8_LDB(B0, 1, 0); PG8_LDB(B1, 1, 1); PG8_SCHED; PG8_LDA(At, 1, 0); PG8_STAGE(PG8_SA(0, 1), a2 + hstepA, voffA);
            PG8_WAIT_V(8); PG8_WAIT_L(0); PG8_BAR; PG8_MMA(0, 0, At, B0); PG8_MMA(0, 1, At, B1); PG8_BAR; PG8_SCHED;
            PG8_LDA(At, 1, 1); PG8_STAGE(PG8_SB(1, 0), b3, voffB); PG8_STAGE(PG8_SB(1, 1), b3 + hstepB, voffB); PG8_STAGE(PG8_SA(1, 0), a3, voffA);
            PG8_WAIT_V(8); PG8_WAIT_L(0); PG8_BAR; PG8_MMA(1, 0, At, B0); PG8_MMA(1, 1, At, B1); PG8_BAR; PG8_SCHED;
            } else {
            PG8_LDB(B0, 0, 0); PG8_SCHED; PG8_LDA(At, 0, 0); PG8_STAGE(PG8_SA(1, 1), a1 + hstepA, voffA);
            PG8_WAIT_L(8); PG8_BAR; PG8_WAIT_L(0); PG8_MMA(0, 0, At, B0); PG8_BAR; PG8_SCHED;
            PG8_LDB(B1, 0, 1); PG8_STAGE(PG8_SB(0, 0), b2, voffB);
            PG8_BAR; PG8_WAIT_L(0); PG8_MMA(0, 1, At, B1); PG8_BAR;
            PG8_LDA(At, 0, 1); PG8_STAGE(PG8_SA(0, 0), a2, voffA);
            PG8_BAR; PG8_WAIT_L(0); PG8_MMA(1, 0, At, B0); PG8_BAR; PG8_SCHED;
            PG8_STAGE(PG8_SB(0, 1), b2 + hstepB, voffB);
            PG8_WAIT_V(6); PG8_BAR; PG8_MMA(1, 1, At, B1); PG8_BAR;
            PG8_LDB(B0, 1, 0); PG8_SCHED; PG8_LDA(At, 1, 0); PG8_STAGE(PG8_SA(0, 1), a2 + hstepA, voffA);
            PG8_WAIT_L(8); PG8_BAR; PG8_WAIT_L(0); PG8_MMA(0, 0, At, B0); PG8_BAR; PG8_SCHED;
            PG8_LDB(B1, 1, 1); PG8_STAGE(PG8_SB(1, 0), b3, voffB);
            PG8_BAR; PG8_WAIT_L(0); PG8_MMA(0, 1, At, B1); PG8_BAR;
            PG8_LDA(At, 1, 1); PG8_STAGE(PG8_SA(1, 0), a3, voffA);
            PG8_BAR; PG8_WAIT_L(0); PG8_MMA(1, 0, At, B0); PG8_BAR; PG8_SCHED;
            PG8_STAGE(PG8_SB(1, 1), b3 + hstepB, voffB);
            PG8_WAIT_V(6); PG8_BAR; PG8_MMA(1, 1, At, B1); PG8_BAR;
            }
        }
        if constexpr (ALIGN_EPI) { if (wr == 0) PG8_BAR; }
        if constexpr (!Epi::AFTER_DRAIN) { E(acc, cur, wr, wc, fr, fq, (const PG8_LAS float*)(lds + ROWTAB_OFF + (ui & 1) * 1024)); S.done(cur); }
        if (!has_next) break;
#pragma unroll
        for (int a = 0; a < 2; ++a)
#pragma unroll
            for (int b = 0; b < 2; ++b)
#pragma unroll
                for (int m = 0; m < 4; ++m)
#pragma unroll
                    for (int n = 0; n < 2; ++n) acc[a][b][m][n] = (f32x4){0.f, 0.f, 0.f, 0.f};
        cur = nxt; cA = nA; cB = nB; ++ui;
        if constexpr (ALIGN_EPI) { if (wr == 1) PG8_BAR; }
    }
    PG8_WAIT_V(0);
    if constexpr (!ALIGN_EPI) { if (wr == 0) PG8_BAR; }
    PG8_BAR;
    if constexpr (Epi::AFTER_DRAIN) { E.fused(acc, cur, wr, wc, fr, fq, lds, wid, lane); S.done(cur); }
#undef PG8_SA
#undef PG8_SB
#undef PG8_STAGE
#undef PG8_LDA
#undef PG8_LDB
#undef PG8_MMA
#undef PG8_WAIT_V
#undef PG8_WAIT_L
#undef PG8_BAR
#undef PG8_SCHED
}
}

constexpr size_t WS_P = 0, WS_XN = 335544320ull, WS_WOUT = 469762048ull, WS_WIN1 = 486539264ull, WS_MKV = 509607936ull, WS_ROPE = 512753664ull, WS_SS = 516947968ull, WS_END = 517472256ull;
constexpr size_t DO_WIN0 = 0, DO_WMKV = 23068672ull, DO_MEMN = 31457280ull;
constexpr int LDS_BYTES = 147456;
constexpr int L_K = 0, L_VT = 49152, L_KM = 0, L_VM = 65536, L_RA = 131072, L_SSQ = 131584;
constexpr int NTHREADS = 512;
constexpr size_t WS_CTL = WS_END + 4096, CTL_BYTES = 16384;
constexpr int L_MISC = 147392;

struct Params {
    const float* x_prompt; const float* x_sample; const float* mem_prompt; const float* mem_sample;
    const float* norm_in; const float* w_in; const float* sink; const float* conv_w; const float* norm_mem; const float* w_mem_kv;
    const float* g_attn; const float* g_conv; const float* g_mem; const float* w_out; const float* final_norm;
    float* out; unsigned char* ws;
};

__device__ const double INVF_REV[32] = {0.15915494309189535, 0.11934937021124886, 0.08949940160889101, 0.06711508300522726, 0.050329212104487035, 0.03774158471741977, 0.0283021958306234, 0.02122365276477766, 0.015915494309189534, 0.011934937021124886, 0.008949940160889102, 0.006711508300522725, 0.005032921210448704, 0.003774158471741977, 0.00283021958306234, 0.0021223652764777662, 0.0015915494309189536, 0.0011934937021124885, 0.0008949940160889102, 0.0006711508300522726, 0.0005032921210448703, 0.00037741584717419774, 0.00028302195830623395, 0.0002122365276477766, 0.00015915494309189535, 0.00011934937021124886, 8.949940160889102e-05, 6.711508300522725e-05, 5.0329212104487035e-05, 3.774158471741978e-05, 2.8302195830623396e-05, 2.122365276477766e-05};

__device__ __forceinline__ float wave_sum(float v, int lane) {
#pragma unroll
    for (int o = 1; o < 64; o <<= 1) v += shx(v, lane, o);
    return v;
}

__device__ __forceinline__ int win_map(int n) {
    if (n < 1024) { const int d = n & 63; return (n & ~63) + 2 * (d & 31) + (d >> 5); }
    if (n < 1280) { const int q = n - 1024, d = q & 63; return 2048 + (q & ~63) + 2 * (d & 31) + (d >> 5); }
    if (n < 1536) return 2304 + (n - 1280);
    if (n < 2560) return 2560 + (n - 1536);
    if (n < 3072) return 1024 + (n - 2560);
    if (n < 3584) { const int ch = n - 3072; return 4608 + 256 * (ch >> 7) + (ch & 127); }
    if (n < 4096) { const int ch = n - 3584; return 4608 + 256 * (ch >> 7) + 128 + (ch & 127); }
    if (n < 4608) return 3584 + (n - 4096);
    if (n < 5120) return 1536 + (n - 4608);
    return 4096 + (n - 5120);
}
template <bool MAPIN>
__device__ __forceinline__ void transpose_item(const float* W, int K, int N, bf16_t* WT, LAS float* scr, int item, int lane, const float* gk = nullptr) {
    const int nblk = N / 32, kb = item / nblk, nb = item % nblk, k0 = 64 * kb, n0 = 32 * nb;
#pragma unroll 8
    for (int i = 0; i < 32; ++i) { const int kk = 2 * i + (lane >> 5); scr[kk * 33 + (lane & 31)] = W[(size_t)(k0 + kk) * N + n0 + (lane & 31)]; }
    asm volatile("s_waitcnt lgkmcnt(0)" ::: "memory");
    const int c = lane & 7;
#pragma unroll
    for (int j = 0; j < 4; ++j) { const int n = (lane >> 3) + 8 * j; const LAS float* s = scr + (8 * c) * 33 + n;
        f32x4 ga = (f32x4){1.f, 1.f, 1.f, 1.f}, gb = ga;
        if (gk) { ga = *(const f32x4*)(gk + k0 + 8 * c); gb = *(const f32x4*)(gk + k0 + 8 * c + 4); }
        u32x4 o; o.x = cvt_pk_bf16(s[0 * 33] * ga[0], s[1 * 33] * ga[1]); o.y = cvt_pk_bf16(s[2 * 33] * ga[2], s[3 * 33] * ga[3]); o.z = cvt_pk_bf16(s[4 * 33] * gb[0], s[5 * 33] * gb[1]); o.w = cvt_pk_bf16(s[6 * 33] * gb[2], s[7 * 33] * gb[3]);
        const int nd = MAPIN ? win_map(n0 + n) : (n0 + n);
        *(u32x4*)(WT + (size_t)nd * K + k0 + 8 * c) = o; }
    asm volatile("s_waitcnt lgkmcnt(0)" ::: "memory");
}

__device__ __forceinline__ void p0_prologue(const Params& p, LAS unsigned char* lds, int vcu_in, int G_in, int cu0, int part) {
    const int tid = threadIdx.x, lane = tid & 63, wave = tid >> 6;
    const int vcu = vcu_in - cu0, G = G_in - cu0;
    if (vcu < 0) return;
    const int gw = vcu * 8 + wave, NGW = G * 8;
    unsigned char* ws = p.ws; unsigned char* dob = (unsigned char*)p.out;
    {
        LAS float* scr = (LAS float*)(lds + wave * 16384);
        constexpr int I_IN = 32 * 176, I_OUT = 32 * 64, I_MKV = 32 * 32, I_L = I_IN + I_OUT;
        if (part == 0) {
            for (int it = gw; it < 2 * I_MKV; it += NGW) { const int l = it / I_MKV, r = it % I_MKV;
                transpose_item<false>(p.w_mem_kv + (size_t)l * 2048 * 1024, 2048, 1024, (bf16_t*)(dob + DO_WMKV) + (size_t)l * 1024 * 2048, scr, r, lane); }
        } else
        for (int it = gw; it < 2 * I_L; it += NGW) {
            const int l = it / I_L; int r = it % I_L;
            if (r < I_IN) { bf16_t* dst = l == 0 ? (bf16_t*)(dob + DO_WIN0) : (bf16_t*)(ws + WS_WIN1);
                transpose_item<true>(p.w_in + (size_t)l * 2048 * 5632, 2048, 5632, dst, scr, r, lane, l == 1 ? p.norm_in + 2048 : nullptr); continue; }
            r -= I_IN;
            { const int k0 = 64 * (r / 64);
              const float* gk = k0 < 1024 ? p.g_attn + l * 1024 : (k0 < 1536 ? p.g_conv + l * 512 - 1024 : p.g_mem + l * 512 - 1536);
              transpose_item<false>(p.w_out + (size_t)l * 2048 * 2048, 2048, 2048, (bf16_t*)(ws + WS_WOUT) + (size_t)l * 2048 * 2048, scr, r, lane, gk); }
        }
    }
    if (part == 1) {
        float* SS0 = (float*)(ws + WS_SS); float* SS1 = SS0 + 32768; float* SSF = SS0 + 65536;
        for (int i = vcu * NTHREADS + tid; i < 32768; i += G * NTHREADS) { SS1[i] = 0.f; SSF[i] = 0.f; }
        f32x4 g[8];
#pragma unroll
        for (int j = 0; j < 8; ++j) g[j] = ((const f32x4*)p.norm_in)[lane + 64 * j];
        bf16_t* XN = (bf16_t*)(ws + WS_XN);
        for (int row = gw; row < T_TOK; row += NGW) {
            const float* xr = row < 16384 ? p.x_prompt + (size_t)row * 2048 : p.x_sample + (size_t)(row - 16384) * 2048;
            f32x4 v[8]; float s = 0.f;
#pragma unroll
            for (int j = 0; j < 8; ++j) { v[j] = ((const f32x4*)xr)[lane + 64 * j]; s += (v[j][0] * v[j][0] + v[j][1] * v[j][1]) + (v[j][2] * v[j][2] + v[j][3] * v[j][3]); }
            s = wave_sum(s, lane);
            if (lane == 0) SS0[row] = s;
            u32x2* o = (u32x2*)(XN + (size_t)row * 2048);
#pragma unroll
            for (int j = 0; j < 8; ++j) { const f32x4 y = v[j] * g[j]; u32x2 w; w.x = cvt_pk_bf16(y[0], y[1]); w.y = cvt_pk_bf16(y[2], y[3]); o[lane + 64 * j] = w; }
        }
    }
    if (part == 0) for (int row = gw; row < MEMROWS; row += NGW) {
        const float* xr = row < 512 ? p.mem_prompt + (size_t)row * 2048 : p.mem_sample + (size_t)(row - 512) * 2048;
        f32x4 v[8]; float s = 0.f;
#pragma unroll
        for (int j = 0; j < 8; ++j) { v[j] = ((const f32x4*)xr)[lane + 64 * j]; s += (v[j][0] * v[j][0] + v[j][1] * v[j][1]) + (v[j][2] * v[j][2] + v[j][3] * v[j][3]); }
        s = wave_sum(s, lane);
        const float rs = rsqrtf(s * (1.0f / 2048.0f) + EPS);
#pragma unroll
        for (int l = 0; l < 2; ++l) {
            u32x2* o = (u32x2*)((bf16_t*)(dob + DO_MEMN) + ((size_t)l * MEMROWS + row) * 2048);
#pragma unroll
            for (int j = 0; j < 8; ++j) { const f32x4 gg = ((const f32x4*)(p.norm_mem + l * 2048))[lane + 64 * j]; const f32x4 y = v[j] * rs * gg;
                u32x2 w; w.x = cvt_pk_bf16(y[0], y[1]); w.y = cvt_pk_bf16(y[2], y[3]); o[lane + 64 * j] = w; }
        }
    }
    if (part == 1) {
        f32x2* rope = (f32x2*)(ws + WS_ROPE);
        for (int i = vcu * NTHREADS + tid; i < 16384 * 32; i += G * NTHREADS) {
            const int pos = i >> 5, fi = i & 31;
            const double rev = (double)pos * INVF_REV[fi];
            const float fr = (float)(rev - __builtin_rint(rev));
            f32x2 cs; cs[0] = __builtin_amdgcn_cosf(fr); cs[1] = __builtin_amdgcn_sinf(fr);
            rope[i] = cs;
        }
    }
}

typedef short v4i16_t __attribute__((ext_vector_type(4)));
#define LBAR() do { asm volatile("s_waitcnt lgkmcnt(0)" ::: "memory"); __builtin_amdgcn_s_barrier(); asm volatile("" ::: "memory"); } while (0)
#define PG(T, BASE, off_elems) (*(GAS T*)((GAS char*)(BASE) + (size_t)((unsigned)(off_elems) * 2u)))
__device__ __forceinline__ void glds16(const GAS void* gsrc, unsigned lds_dst) { unsigned keep;
    asm volatile("s_mov_b32 %0, m0\n\ts_mov_b32 m0, %2\n\ts_nop 0\n\tglobal_load_lds_dwordx4 %1, off\n\ts_mov_b32 m0, %0" : "=&s"(keep) : "v"(gsrc), "s"(lds_dst) : "memory"); }
__device__ __forceinline__ int slot_of(int kappa) { const int kq = kappa & 31; return (kappa & ~31) + 16 * ((kq >> 2) & 1) + 4 * (kq >> 3) + (kq & 3); }
__device__ __forceinline__ v4i16_t tr16(LAS unsigned char* a) { return __builtin_amdgcn_ds_read_tr16_b64_v4i16((LAS v4i16_t*)a); }

__device__ __forceinline__ void load_z8(const GAS bf16_t* P, int t, int s0, int s1, int lane, float (&z)[8]) {
    if (t >= s0 && t < s1) { const u32x4 v = *(const GAS u32x4*)(P + (size_t)t * PW + C_Z + 8 * lane);
        z[0] = bf_lo(v.x); z[1] = bf_hi(v.x); z[2] = bf_lo(v.y); z[3] = bf_hi(v.y); z[4] = bf_lo(v.z); z[5] = bf_hi(v.z); z[6] = bf_lo(v.w); z[7] = bf_hi(v.w); }
    else {
#pragma unroll
        for (int j = 0; j < 8; ++j) z[j] = 0.f; }
}

__device__ __forceinline__ void mixer_unit(const Params& p, LAS unsigned char* lds, int tile, int layer, int wave_s) {
    int tid_ = wave_s * 64 + lane_id_opaque(); asm volatile("" : "+v"(tid_));
    const int tid = tid_, lane = tid & 63, wave = __builtin_amdgcn_readfirstlane(tid >> 6), rho = lane & 15, g = lane >> 4;
    unsigned char* wsb = p.ws; asm volatile("" : "+s"(wsb));
    GAS bf16_t* P = (GAS bf16_t*)(wsb + WS_P);
    const int tile0 = tile * 128;
    int s0, s1, ms;
    if (tile0 < 8192) { s0 = 0; s1 = 8192; ms = 0; } else if (tile0 < 16384) { s0 = 8192; s1 = 16384; ms = 1; } else { s0 = 16384; s1 = 32768; ms = 2; }
    const bool first = (tile0 == s0), last = (tile0 + 128 == s1);
    LAS float* RAs = (LAS float*)(lds + L_RA);
    LAS float* SSQ = (LAS float*)(lds + L_SSQ);
    const GAS float* sinkp = (const GAS float*)p.sink + layer * 16;

    const bf16x8 ONES8 = (bf16x8){0x3F80, 0x3F80, 0x3F80, 0x3F80, 0x3F80, 0x3F80, 0x3F80, 0x3F80};
    if (wave >= 4) __builtin_amdgcn_s_setprio(1);
    {
        const int fv = (rho >> 2) | ((g & 1) << 2);
        const int vlane = (8 * g + (rho >> 2)) * 128;
        u32x4 kreg[6], vreg[6];
#define WIN_PREFETCH(KVH) do { _Pragma("unroll") for (int j = 0; j < 6; ++j) { \
                const int idx = tid + NTHREADS * j, kap = idx >> 3, ch = idx & 7, trow = tile0 - 128 + kap; \
                const bool ok = (trow >= s0 && trow < s1); const unsigned tr_c = (unsigned)(ok ? trow : tile0); \
                const unsigned so = tr_c * (unsigned)PW + (unsigned)((KVH) * 64 + ch * 8); \
                const u32x4 kk = PG(const u32x4, P, so + C_K), vv = PG(const u32x4, P, so + C_V); \
                kreg[j] = ok ? kk : (u32x4){0u, 0u, 0u, 0u}; vreg[j] = ok ? vv : (u32x4){0u, 0u, 0u, 0u}; } } while (0)
        WIN_PREFETCH(0);
        const bool inv_lo = first, inv_hi = last;
        bf16x8 qf[2];
        {
            const unsigned q0 = (unsigned)(tile0 + (wave & 1) * 64 + rho) * (unsigned)PW + (unsigned)(C_Q + (wave >> 1) * 64 + 8 * g);
            qf[0] = PG(const bf16x8, P, q0); qf[1] = PG(const bf16x8, P, q0 + 32);
        }
        for (int kvh = 0; kvh < 4; ++kvh) {
            const int hq = kvh * 4 + (wave >> 1), rhalf = (wave & 1) * 64;
            LBAR();
#pragma unroll
            for (int j = 0; j < 6; ++j) {
                const int idx = tid + NTHREADS * j, kap = idx >> 3, ch = idx & 7;
                const int sl = slot_of(kap);
                *(LAS u32x4*)(lds + L_K + sl * 128 + ((ch ^ (sl & 7)) << 4)) = kreg[j];
                const int fk = (kap & 3) | (((kap >> 3) & 1) << 2);
                *(LAS u32x4*)(lds + L_VT + kap * 128 + ((ch ^ fk) << 4)) = vreg[j];
            }
            LBAR();
#ifndef NO_WPF
            if (kvh < 3) WIN_PREFETCH(kvh + 1);
#endif
            const float sink = sinkp[hq];
#pragma unroll 1
            for (int qt = 0; qt < 4; ++qt) {
                const int a = rhalf + 16 * qt, trow = tile0 + a + rho;
                const unsigned prow = (unsigned)trow * (unsigned)PW + (unsigned)(hq * 64 + 8 * g);
                u32x4 gt[2];
#pragma unroll
                for (int j = 0; j < 2; ++j) gt[j] = PG(const u32x4, P, prow + C_GA + 32 * j);
                bf16x8 qn[2];
                {
                    const unsigned q1 = (unsigned)(tile0 + rhalf + 16 * ((qt + 1) & 3) + rho) * (unsigned)PW + (unsigned)(C_Q + (qt == 3 ? hq + 4 : hq) * 64 + 8 * g);
                    qn[0] = PG(const bf16x8, P, q1); qn[1] = PG(const bf16x8, P, q1 + 32);
                }
                const int beta0 = a >> 5, qq = (a & 31) + rho;
                f32x4 S[9][2];
#pragma unroll
                for (int c = 0; c < 9; ++c) {
                    const int beta = beta0 + c;
#pragma unroll
                    for (int w = 0; w < 2; ++w) {
                        const int sl = 32 * beta + 16 * w + rho;
                        const bf16x8 k0 = *(const LAS bf16x8*)(lds + L_K + sl * 128 + ((g ^ (sl & 7)) << 4));
                        const bf16x8 k1 = *(const LAS bf16x8*)(lds + L_K + sl * 128 + (((4 + g) ^ (sl & 7)) << 4));
                        f32x4 acc = (f32x4){0.f, 0.f, 0.f, 0.f};
                        acc = __builtin_amdgcn_mfma_f32_16x16x32_bf16(k0, qf[0], acc, 0, 0, 0);
                        acc = __builtin_amdgcn_mfma_f32_16x16x32_bf16(k1, qf[1], acc, 0, 0, 0);
                        S[c][w] = acc;
                    }
                    if (c == 0) {
#pragma unroll
                        for (int w = 0; w < 2; ++w)
#pragma unroll
                            for (int r = 0; r < 4; ++r) S[c][w][r] = (8 * g + 4 * w + r < qq) ? -INFINITY : S[c][w][r];
                    }
                    if (c == 8) {
#pragma unroll
                        for (int w = 0; w < 2; ++w)
#pragma unroll
                            for (int r = 0; r < 4; ++r) S[c][w][r] = (8 * g + 4 * w + r > qq) ? -INFINITY : S[c][w][r];
                    }
                }
                if (inv_lo || inv_hi) {
#pragma unroll
                    for (int c = 0; c < 9; ++c) {
                        const int beta = beta0 + c;
                        const bool cinv = (inv_lo && beta < 4) || (inv_hi && beta >= 8);
#pragma unroll
                        for (int w = 0; w < 2; ++w)
#pragma unroll
                            for (int r = 0; r < 4; ++r) S[c][w][r] = cinv ? -INFINITY : S[c][w][r];
                    }
                }
                float mx = sink;
#pragma unroll
                for (int c = 0; c < 9; ++c)
#pragma unroll
                    for (int w = 0; w < 2; ++w) { mx = __builtin_fmaxf(__builtin_fmaxf(mx, S[c][w][0]), S[c][w][1]); mx = __builtin_fmaxf(__builtin_fmaxf(mx, S[c][w][2]), S[c][w][3]); }
                mx = fmaxf(mx, shx(mx, lane, 16)); mx = x32_max(mx);
                const float mb = mx * LOG2E;
#pragma unroll
                for (int c = 0; c < 9; ++c)
#pragma unroll
                    for (int w = 0; w < 2; ++w)
#pragma unroll
                        for (int r = 0; r < 4; ++r) S[c][w][r] = __builtin_amdgcn_exp2f(S[c][w][r] * LOG2E - mb);
                f32x4 OS = (f32x4){0.f, 0.f, 0.f, 0.f};
                f32x4 O[4];
                LAS unsigned char* vbd[4];
#pragma unroll
                for (int dt = 0; dt < 4; ++dt) { O[dt] = (f32x4){0.f, 0.f, 0.f, 0.f}; vbd[dt] = lds + L_VT + vlane + beta0 * 4096 + ((((4 * (dt >> 1) + (rho & 3)) ^ fv) << 4) + 8 * (dt & 1)); }
#pragma unroll
                for (int c = 0; c < 9; ++c) {
                    const int beta = beta0 + c;
                    u32x4 pw; pw.x = cvt_pk_bf16(S[c][0][0], S[c][0][1]); pw.y = cvt_pk_bf16(S[c][0][2], S[c][0][3]); pw.z = cvt_pk_bf16(S[c][1][0], S[c][1][1]); pw.w = cvt_pk_bf16(S[c][1][2], S[c][1][3]);
                    const bf16x8 pf = __builtin_bit_cast(bf16x8, pw);
                    OS = __builtin_amdgcn_mfma_f32_16x16x32_bf16(ONES8, pf, OS, 0, 0, 0);
#pragma unroll
                    for (int dt = 0; dt < 4; ++dt) {
                        const v4i16_t lo = tr16(vbd[dt] + c * 4096), hi = tr16(vbd[dt] + c * 4096 + 512);
                        const bf16x8 vf = (bf16x8){lo[0], lo[1], lo[2], lo[3], hi[0], hi[1], hi[2], hi[3]};
                        O[dt] = __builtin_amdgcn_mfma_f32_16x16x32_bf16(vf, pf, O[dt], 0, 0, 0);
                    }
                }
                const float il = __builtin_amdgcn_rcpf(OS[0] + __builtin_amdgcn_exp2f(sink * LOG2E - mb));
                float ssq = 0.f;
#pragma unroll
                for (int j = 0; j < 2; ++j) {
                    const f32x4 o0 = O[2 * j] * il, o1 = O[2 * j + 1] * il;
                    ssq += (o0[0] * o0[0] + o0[1] * o0[1]) + (o0[2] * o0[2] + o0[3] * o0[3]) + (o1[0] * o1[0] + o1[1] * o1[1]) + (o1[2] * o1[2] + o1[3] * o1[3]);
                    u32x4 w;
                    w.x = cvt_pk_bf16(o0[0] * silu_f(bf_lo(gt[j].x)), o0[1] * silu_f(bf_hi(gt[j].x)));
                    w.y = cvt_pk_bf16(o0[2] * silu_f(bf_lo(gt[j].y)), o0[3] * silu_f(bf_hi(gt[j].y)));
                    w.z = cvt_pk_bf16(o1[0] * silu_f(bf_lo(gt[j].z)), o1[1] * silu_f(bf_hi(gt[j].z)));
                    w.w = cvt_pk_bf16(o1[2] * silu_f(bf_lo(gt[j].w)), o1[3] * silu_f(bf_hi(gt[j].w)));
                    PG(u32x4, P, prow + C_Q + 32 * j) = w;
                }
                ssq += shx(ssq, lane, 16); ssq = x32_sum(ssq);
                if (g == 0) SSQ[hq * 128 + a + rho] = ssq;
                qf[0] = qn[0]; qf[1] = qn[1];
            }
        }
#undef WIN_PREFETCH
    }

    {
        const int lane = lane_id_opaque();
        const GAS float* cw = (const GAS float*)p.conv_w + layer * 3 * 512 + 8 * lane;
        float w0[8], w1[8], w2[8];
#pragma unroll
        for (int j = 0; j < 8; ++j) { w0[j] = cw[j]; w1[j] = cw[512 + j]; w2[j] = cw[1024 + j]; }
        const int tb = tile0 + 16 * wave;
        u32x4 zr[18];
#pragma unroll
        for (int k = 0; k < 18; ++k) {
            const int t = tb - 1 + k; const bool ok = (t >= s0 && t < s1);
            const u32x4 v = PG(const u32x4, P, (unsigned)(ok ? t : tb) * (unsigned)PW + (unsigned)(C_Z + 8 * lane));
            zr[k] = ok ? v : (u32x4){0u, 0u, 0u, 0u};
        }
        u32x4 cbv[4], gtv[4];
#pragma unroll
        for (int ii = 0; ii < 4; ++ii) { const unsigned ro = (unsigned)(tb + ii) * (unsigned)PW + (unsigned)(8 * lane); cbv[ii] = PG(const u32x4, P, ro + C_CB); gtv[ii] = PG(const u32x4, P, ro + C_GC); }
    __syncthreads();
    if (tid < 128) {
        float s = 0.f;
#pragma unroll
        for (int h = 0; h < 16; ++h) s += SSQ[h * 128 + tid];
        const float ra = rsqrtf(s * (1.0f / 1024.0f) + EPS);
        RAs[tid] = ra;
        ((GAS float*)(wsb + WS_SS))[98304 + tile0 + tid] = ra;
    }
    __syncthreads();
    {
        const int ln = lane_id_opaque();
        const GAS bf16_t* MKV0 = (const GAS bf16_t*)(wsb + WS_MKV) + (size_t)layer * MEMROWS * 1024 + (size_t)ms * 256 * 1024;
        const unsigned ldsb0 = (unsigned)(uintptr_t)lds;
#pragma unroll
        for (int j = 0; j < 8; ++j) {
            const int row = (wave * 8 + j) * 4 + (ln >> 4), pc = ln & 15;
            const int kq = row & 31, kap = (row & ~31) + 8 * ((kq >> 2) & 3) + 4 * (kq >> 4) + (kq & 3);
            glds16((const GAS void*)(MKV0 + (unsigned)kap * 1024u + (unsigned)((pc ^ (row & 15)) * 8)), (unsigned)__builtin_amdgcn_readfirstlane(ldsb0 + L_KM + (wave * 8 + j) * 1024));
        }
#pragma unroll
        for (int j = 0; j < 8; ++j) {
            const int row = (wave * 8 + j) * 4 + (ln >> 4), pc = ln & 15;
            const int fk = ((row & 3) << 1) | (((row >> 3) & 1) << 3);
            glds16((const GAS void*)(MKV0 + (unsigned)row * 1024u + 512u + (unsigned)((pc ^ fk) * 8)), (unsigned)__builtin_amdgcn_readfirstlane(ldsb0 + L_VM + (wave * 8 + j) * 1024));
        }
    }
#pragma unroll
        for (int gi = 0; gi < 4; ++gi) {
            u32x4 cbn[4], gtn[4];
#pragma unroll
            for (int ii = 0; ii < 4; ++ii) { const unsigned ro = (unsigned)(tb + (gi < 3 ? 4 * gi + 4 + ii : ii)) * (unsigned)PW + (unsigned)(8 * lane); cbn[ii] = PG(const u32x4, P, ro + C_CB); gtn[ii] = PG(const u32x4, P, ro + C_GC); }
            float yv[4][8], sq[4];
#pragma unroll
            for (int ii = 0; ii < 4; ++ii) {
                const int i = 4 * gi + ii;
                const u32x4 a = zr[i], c = zr[i + 1], n = zr[i + 2], cbw = cbv[ii];
                const float zp[8] = {bf_lo(a.x), bf_hi(a.x), bf_lo(a.y), bf_hi(a.y), bf_lo(a.z), bf_hi(a.z), bf_lo(a.w), bf_hi(a.w)};
                const float zc[8] = {bf_lo(c.x), bf_hi(c.x), bf_lo(c.y), bf_hi(c.y), bf_lo(c.z), bf_hi(c.z), bf_lo(c.w), bf_hi(c.w)};
                const float zn[8] = {bf_lo(n.x), bf_hi(n.x), bf_lo(n.y), bf_hi(n.y), bf_lo(n.z), bf_hi(n.z), bf_lo(n.w), bf_hi(n.w)};
                const float cb[8] = {bf_lo(cbw.x), bf_hi(cbw.x), bf_lo(cbw.y), bf_hi(cbw.y), bf_lo(cbw.z), bf_hi(cbw.z), bf_lo(cbw.w), bf_hi(cbw.w)};
                float q = 0.f;
#pragma unroll
                for (int j = 0; j < 8; ++j) { yv[ii][j] = cb[j] * (w0[j] * zp[j] + w1[j] * zc[j] + w2[j] * zn[j]); q += yv[ii][j] * yv[ii][j]; }
                sq[ii] = q;
            }
#pragma unroll
            for (int o = 1; o < 64; o <<= 1)
#pragma unroll
                for (int ii = 0; ii < 4; ++ii) sq[ii] += shx(sq[ii], lane, o);
#pragma unroll
            for (int ii = 0; ii < 4; ++ii) {
                const int i = 4 * gi + ii, t = tb + i;
                const u32x4 gtw = gtv[ii];
                const float gt[8] = {bf_lo(gtw.x), bf_hi(gtw.x), bf_lo(gtw.y), bf_hi(gtw.y), bf_lo(gtw.z), bf_hi(gtw.z), bf_lo(gtw.w), bf_hi(gtw.w)};
                const float sc = rsqrtf(sq[ii] * (1.0f / 512.0f) + EPS) * __builtin_amdgcn_rcpf(RAs[16 * wave + i]);
                u32x4 o;
                o.x = cvt_pk_bf16(yv[ii][0] * sc * silu_f(gt[0]), yv[ii][1] * sc * silu_f(gt[1]));
                o.y = cvt_pk_bf16(yv[ii][2] * sc * silu_f(gt[2]), yv[ii][3] * sc * silu_f(gt[3]));
                o.z = cvt_pk_bf16(yv[ii][4] * sc * silu_f(gt[4]), yv[ii][5] * sc * silu_f(gt[5]));
                o.w = cvt_pk_bf16(yv[ii][6] * sc * silu_f(gt[6]), yv[ii][7] * sc * silu_f(gt[7]));
                PG(u32x4, P, (unsigned)t * (unsigned)PW + (unsigned)(C_CB + 8 * lane)) = o;
            }
#pragma unroll
            for (int ii = 0; ii < 4; ++ii) { cbv[ii] = cbn[ii]; gtv[ii] = gtn[ii]; }
        }
    }

    {
        const int lane = lane_id_opaque(), rho = lane & 15, g = lane >> 4;
        const GAS bf16_t* MKV = (const GAS bf16_t*)(wsb + WS_MKV) + (size_t)layer * MEMROWS * 1024 + (size_t)ms * 256 * 1024;
        const int a = 16 * wave, trow = tile0 + a + rho;
        GAS bf16_t* prow = P + (size_t)trow * PW;
        const float scl = 0.08838834764831845f * LOG2E;
        const int fm = ((rho >> 2) << 1) | ((g & 1) << 3);
        const int vlane = (8 * g + (rho >> 2)) * 256;
        unsigned ksrc[8], vsrc[8];
#pragma unroll
        for (int j = 0; j < 8; ++j) {
            const int row = (wave * 8 + j) * 4 + (lane >> 4), pc = lane & 15;
            const int kq = row & 31, kap = (row & ~31) + 8 * ((kq >> 2) & 3) + 4 * (kq >> 4) + (kq & 3);
            ksrc[j] = (unsigned)kap * 1024u + (unsigned)((pc ^ (row & 15)) * 8);
            const int fk = ((row & 3) << 1) | (((row >> 3) & 1) << 3);
            vsrc[j] = (unsigned)row * 1024u + 512u + (unsigned)((pc ^ fk) * 8);
        }
        const unsigned ldsb = (unsigned)(uintptr_t)lds;
#define MEM_DMA_K(H) do { _Pragma("unroll") for (int j = 0; j < 8; ++j) \
            glds16((const GAS void*)(MKV + ksrc[j] + (H) * 128), (unsigned)__builtin_amdgcn_readfirstlane(ldsb + L_KM + (wave * 8 + j) * 1024)); } while (0)
#define MEM_DMA_V(H) do { _Pragma("unroll") for (int j = 0; j < 8; ++j) \
            glds16((const GAS void*)(MKV + vsrc[j] + (H) * 128), (unsigned)__builtin_amdgcn_readfirstlane(ldsb + L_VM + (wave * 8 + j) * 1024)); } while (0)
#define VBAR() do { asm volatile("s_waitcnt vmcnt(0) lgkmcnt(0)" ::: "memory"); __builtin_amdgcn_s_barrier(); asm volatile("" ::: "memory"); } while (0)
        bf16x8 qf[4];
#pragma unroll
        for (int ks = 0; ks < 4; ++ks) qf[ks] = *(const GAS bf16x8*)(prow + C_MQ + 32 * ks + 8 * g);
        float ssq = 0.f;
#pragma unroll 1
        for (int h = 0; h < 4; ++h) {
            VBAR();
            if (h > 0) MEM_DMA_V(h);
            f32x4 S[8][2];
            {
                LAS unsigned char* kb = lds + L_KM + rho * 256;
                const int kx0 = ((0 + g) ^ rho) << 4, kx1 = ((4 + g) ^ rho) << 4, kx2 = ((8 + g) ^ rho) << 4, kx3 = ((12 + g) ^ rho) << 4;
                bf16x8 kf[2][4];
#define KLD(T, B) do { LAS unsigned char* kp_ = kb + (T) * 4096; kf[B][0] = *(const LAS bf16x8*)(kp_ + kx0); kf[B][1] = *(const LAS bf16x8*)(kp_ + kx1); \
                       kf[B][2] = *(const LAS bf16x8*)(kp_ + kx2); kf[B][3] = *(const LAS bf16x8*)(kp_ + kx3); } while (0)
                KLD(0, 0);
#pragma unroll
                for (int t = 0; t < 16; ++t) {
                    if (t + 1 < 16) KLD(t + 1, (t + 1) & 1);
                    __builtin_amdgcn_sched_barrier(0);
                    f32x4 acc = (f32x4){0.f, 0.f, 0.f, 0.f};
#pragma unroll
                    for (int ks = 0; ks < 4; ++ks) acc = __builtin_amdgcn_mfma_f32_16x16x32_bf16(kf[t & 1][ks], qf[ks], acc, 0, 0, 0);
                    S[t >> 1][t & 1] = acc;
                    __builtin_amdgcn_sched_barrier(0);
                }
#undef KLD
            }
            float mx = -INFINITY;
#pragma unroll
            for (int c = 0; c < 8; ++c)
#pragma unroll
                for (int w = 0; w < 2; ++w) { mx = __builtin_fmaxf(__builtin_fmaxf(mx, S[c][w][0]), S[c][w][1]); mx = __builtin_fmaxf(__builtin_fmaxf(mx, S[c][w][2]), S[c][w][3]); }
            mx = fmaxf(mx, shx(mx, lane, 16)); mx = x32_max(mx);
            const float mb = mx * scl;
#pragma unroll
            for (int c = 0; c < 8; ++c)
#pragma unroll
                for (int w = 0; w < 2; ++w)
#pragma unroll
                    for (int r = 0; r < 4; ++r) S[c][w][r] = __builtin_amdgcn_exp2f(S[c][w][r] * scl - mb);
            f32x4 OS = (f32x4){0.f, 0.f, 0.f, 0.f};
            VBAR();
            if (h < 3) {
                MEM_DMA_K(h + 1);
#pragma unroll
                for (int ks = 0; ks < 4; ++ks) qf[ks] = *(const GAS bf16x8*)(prow + C_MQ + (h + 1) * 128 + 32 * ks + 8 * g);
            }
            f32x4 O[8];
#pragma unroll
            for (int dt = 0; dt < 8; ++dt) O[dt] = (f32x4){0.f, 0.f, 0.f, 0.f};
            {
                bf16x8 pf[8];
#pragma unroll
                for (int c = 0; c < 8; ++c) { u32x4 pw; pw.x = cvt_pk_bf16(S[c][0][0], S[c][0][1]); pw.y = cvt_pk_bf16(S[c][0][2], S[c][0][3]); pw.z = cvt_pk_bf16(S[c][1][0], S[c][1][1]); pw.w = cvt_pk_bf16(S[c][1][2], S[c][1][3]);
                    pf[c] = __builtin_bit_cast(bf16x8, pw); }
                LAS unsigned char* vb = lds + L_VM + vlane;
                v4i16_t vlo[2], vhi[2];
#define VLD(I, B) do { const int c_ = (I) >> 3, dt_ = (I) & 7; const int co_ = (((4 * (dt_ >> 1) + (rho & 3)) ^ fm) << 4) + 8 * (dt_ & 1); vlo[B] = tr16(vb + c_ * 8192 + co_); vhi[B] = tr16(vb + c_ * 8192 + 1024 + co_); } while (0)
                VLD(0, 0);
#pragma unroll
                for (int i = 0; i < 64; ++i) {
                    if (i + 1 < 64) VLD(i + 1, (i + 1) & 1);
                    if ((i & 7) == 0) OS = __builtin_amdgcn_mfma_f32_16x16x32_bf16(ONES8, pf[i >> 3], OS, 0, 0, 0);
                    __builtin_amdgcn_sched_barrier(0);
                    const bf16x8 vf = (bf16x8){vlo[i & 1][0], vlo[i & 1][1], vlo[i & 1][2], vlo[i & 1][3], vhi[i & 1][0], vhi[i & 1][1], vhi[i & 1][2], vhi[i & 1][3]};
                    O[i & 7] = __builtin_amdgcn_mfma_f32_16x16x32_bf16(vf, pf[i >> 3], O[i & 7], 0, 0, 0);
                    __builtin_amdgcn_sched_barrier(0);
                }
#undef VLD
            }
            const float il = __builtin_amdgcn_rcpf(OS[0]);
#pragma unroll
            for (int j = 0; j < 4; ++j) {
                const f32x4 o0 = O[2 * j] * il, o1 = O[2 * j + 1] * il;
                ssq += (o0[0] * o0[0] + o0[1] * o0[1]) + (o0[2] * o0[2] + o0[3] * o0[3]) + (o1[0] * o1[0] + o1[1] * o1[1]) + (o1[2] * o1[2] + o1[3] * o1[3]);
                u32x4 w; w.x = cvt_pk_bf16(o0[0], o0[1]); w.y = cvt_pk_bf16(o0[2], o0[3]); w.z = cvt_pk_bf16(o1[0], o1[1]); w.w = cvt_pk_bf16(o1[2], o1[3]);
                *(GAS u32x4*)(prow + C_MQ + h * 128 + 32 * j + 8 * g) = w;
            }
        }
#undef MEM_DMA_K
#undef MEM_DMA_V
        ssq += shx(ssq, lane, 16); ssq = x32_sum(ssq);
        const float sc = rsqrtf(ssq * (1.0f / 512.0f) + EPS) * __builtin_amdgcn_rcpf(RAs[a + rho]);
        u32x4 ovr[16], gtr[16];
#pragma unroll
        for (int i = 0; i < 16; ++i) { const int col = (i >> 2) * 128 + 32 * (i & 3) + 8 * g; ovr[i] = *(const GAS u32x4*)(prow + C_MQ + col); gtr[i] = *(const GAS u32x4*)(prow + C_GM + col); }
#pragma unroll
        for (int h = 0; h < 4; ++h) {
#pragma unroll
            for (int j = 0; j < 4; ++j) {
                const int col = h * 128 + 32 * j + 8 * g;
                const u32x4 ov = ovr[4 * h + j], gt = gtr[4 * h + j];
                u32x4 w;
                w.x = cvt_pk_bf16(bf_lo(ov.x) * sc * silu_f(bf_lo(gt.x)), bf_hi(ov.x) * sc * silu_f(bf_hi(gt.x)));
                w.y = cvt_pk_bf16(bf_lo(ov.y) * sc * silu_f(bf_lo(gt.y)), bf_hi(ov.y) * sc * silu_f(bf_hi(gt.y)));
                w.z = cvt_pk_bf16(bf_lo(ov.z) * sc * silu_f(bf_lo(gt.z)), bf_hi(ov.z) * sc * silu_f(bf_hi(gt.z)));
                w.w = cvt_pk_bf16(bf_lo(ov.w) * sc * silu_f(bf_lo(gt.w)), bf_hi(ov.w) * sc * silu_f(bf_hi(gt.w)));
                *(GAS u32x4*)(prow + C_MQ + col) = w;
            }
        }
    }
    VBAR();
    __builtin_amdgcn_s_setprio(0);
#undef VBAR
}

#define XB_TMO      128
#define XB_XCNT(j)  (256  + 64 * (j))
#define XB_XSUB(j)  (1280 + 64 * (j))
#define XB_XGEN(j)  (2304 + 64 * (j))
#define XB_TOP      3328
#define XB_TOPGEN   3392
#define XCD_BAR_WORDS 3456
#define XB_SPIN_CAP (1u << 18)

__device__ __forceinline__ unsigned xb_ld(unsigned* p)              { return __hip_atomic_load(p, __ATOMIC_RELAXED, __HIP_MEMORY_SCOPE_AGENT); }
__device__ __forceinline__ unsigned xb_add(unsigned* p, unsigned v) { return __hip_atomic_fetch_add(p, v, __ATOMIC_RELAXED, __HIP_MEMORY_SCOPE_AGENT); }
__device__ __forceinline__ unsigned xb_xcc_id() { return (unsigned)__builtin_amdgcn_s_getreg((3 << 11) | 20) & 0xFu; }
#define XB_SPIN(cond, bar) do { unsigned _sp = 0; while (cond) { __builtin_amdgcn_s_sleep(1); \
    if ((++_sp & 255u) == 0u) { if (xb_ld(&(bar)[XB_TMO])) break; if (_sp > XB_SPIN_CAP) { atomicAdd(&(bar)[XB_TMO], 1u); break; } } } } while (0)

struct XcdBarrier {
    unsigned* bar; unsigned x;
    volatile LAS unsigned* st;
};

__device__ __forceinline__ XcdBarrier xcd_barrier_post(unsigned* bar, volatile LAS unsigned* st) {
    XcdBarrier b; b.bar = bar; b.x = xb_xcc_id(); b.st = st;
    if (threadIdx.x == 0) (void)xb_add(&bar[XB_XCNT(b.x)], 1u);
    return b;
}
__device__ __forceinline__ void xcd_barrier_complete(unsigned* bar, unsigned x, unsigned& nloc, unsigned& nx) {
    const unsigned G = gridDim.x * gridDim.y * gridDim.z;
    unsigned sum, cnt, mine, sp = 0u;
    for (;;) {
        sum = 0u; cnt = 0u; mine = 0u;
#pragma unroll
        for (unsigned j = 0; j < 16; ++j) { const unsigned c = xb_ld(&bar[XB_XCNT(j)]); sum += c; cnt += (c > 0u) ? 1u : 0u; mine = (j == x) ? c : mine; }
        if (sum == G) break;
        __builtin_amdgcn_s_sleep(1);
        if ((++sp & 255u) == 0u) { if (xb_ld(&bar[XB_TMO])) break; if (sp > XB_SPIN_CAP) { atomicAdd(&bar[XB_TMO], 1u); break; } }
    }
    nloc = mine > 0u ? mine : 1u; nx = cnt > 0u ? cnt : 1u;
}

__device__ __forceinline__ void xcd_barrier(const XcdBarrier& b, bool leader) {
    asm volatile("s_waitcnt vmcnt(0)" ::: "memory");
    __syncthreads();
    if (leader) {
        unsigned* bar = b.bar; unsigned bx_ = b.x; asm volatile("" : "+s"(bar), "+s"(bx_));
        __builtin_amdgcn_s_waitcnt(0);
        unsigned nloc = b.st[0], nx = b.st[1];
        if (nloc == 0u) { xcd_barrier_complete(bar, bx_, nloc, nx); b.st[0] = nloc; b.st[1] = nx; }
        const unsigned old = xb_add(&bar[XB_XSUB(bx_)], 1u);
        const unsigned gen = old / nloc;
        if (old + 1u == (gen + 1u) * nloc) {
            __builtin_amdgcn_fence(__ATOMIC_RELEASE, "agent");
            asm volatile("s_waitcnt vmcnt(0)" ::: "memory");
            const unsigned og = xb_add(&bar[XB_TOP], 1u);
            const unsigned tg = og / nx;
            if (og + 1u == (tg + 1u) * nx) xb_add(&bar[XB_TOPGEN], 1u);
            else XB_SPIN(xb_ld(&bar[XB_TOPGEN]) == tg, bar);
            __builtin_amdgcn_fence(__ATOMIC_ACQUIRE, "agent");
            xb_add(&bar[XB_XGEN(bx_)], 1u);
            asm volatile("s_waitcnt vmcnt(0)" ::: "memory");
        } else {
            XB_SPIN(xb_ld(&bar[XB_XGEN(bx_)]) == gen, bar);
            __builtin_amdgcn_fence(__ATOMIC_ACQUIRE, "agent");
            asm volatile("s_waitcnt vmcnt(0)" ::: "memory");
        }
    }
    __syncthreads();
}

__global__ void __launch_bounds__(NTHREADS, 2) __attribute__((amdgpu_waves_per_eu(2, 2))) hymba_fwd(Params p) {
    extern __shared__ __attribute__((aligned(16))) unsigned char lds_raw[];
    LAS unsigned char* lds = (LAS unsigned char*)lds_raw;
    cg::grid_group grid = cg::this_grid();
    const int G = gridDim.x, bx = blockIdx.x;
    const int wave_s = __builtin_amdgcn_readfirstlane(threadIdx.x >> 6);
    const int vcu = (G % 8 == 0) ? (bx % 8) * (G / 8) + bx / 8 : bx;
    unsigned char* ws = p.ws; unsigned char* dob = (unsigned char*)p.out;
    bf16_t* P = (bf16_t*)(ws + WS_P); bf16_t* XN = (bf16_t*)(ws + WS_XN);
    float* SS0 = (float*)(ws + WS_SS); float* SS1 = SS0 + 32768; float* SSF = SS0 + 65536; float* RA = SS0 + 98304;
    const f32x2* rope = (const f32x2*)(ws + WS_ROPE);

#ifndef NO_P0
    if (threadIdx.x == 0) { ((LAS unsigned*)(lds + L_MISC))[0] = 0u; ((LAS unsigned*)(lds + L_MISC))[1] = 0u; }
    __syncthreads();
    XcdBarrier xbar = xcd_barrier_post((unsigned*)(ws + WS_CTL), (volatile LAS unsigned*)(lds + L_MISC));
    if (G == 0x7fffffff) grid.sync();
    constexpr int NMEMCU = 24;
    p0_prologue(p, lds, bx, G, 0, 0);
    xcd_barrier(xbar, wave_s == 0 && lane_id_opaque() == 0);
    if (bx < NMEMCU) {
        const int l = bx / 12;
        pg8::Gemm g2{(const bf16_t*)(dob + DO_MEMN) + (size_t)l * MEMROWS * 2048, (const bf16_t*)(dob + DO_WMKV) + (size_t)l * 1024 * 2048, MEMROWS, 1024, DM, DM};
        pg8::StaticOrder S2; S2.init(MEMROWS, 1024, G, bx % 12);
        pg8::EpiPlain E2{(bf16_t*)(ws + WS_MKV) + (size_t)l * MEMROWS * 1024, 1024, nullptr};
        pg8::gemm_phase<pg8::EpiPlain, pg8::StaticOrder, true>(lds, g2, S2, E2, wave_s);
    }
    p0_prologue(p, lds, bx, G, NMEMCU, 1);
#endif
    xcd_barrier(xbar, wave_s == 0 && lane_id_opaque() == 0);

#pragma unroll 1
    for (int layer = 0; layer < 2; ++layer) {
        asm volatile("" : "+s"(ws), "+s"(dob));
        P = (bf16_t*)(ws + WS_P); XN = (bf16_t*)(ws + WS_XN); SS0 = (float*)(ws + WS_SS); SS1 = SS0 + 32768; SSF = SS0 + 65536; RA = SS0 + 98304; rope = (const f32x2*)(ws + WS_ROPE);
        float* outp = (float*)dob;
        {
            const bf16_t* Wt = layer == 0 ? (const bf16_t*)(dob + DO_WIN0) : (const bf16_t*)(ws + WS_WIN1);
            pg8::Gemm gm{XN, Wt, T_TOK, NIN, DM, DM};
            pg8::StaticOrder S; S.init(T_TOK, NIN, G, bx);
            pg8::EpiIn E{P, layer == 0 ? SS0 : SS1, rope};
#ifndef NO_G1
            pg8::gemm_phase<pg8::EpiIn, pg8::StaticOrder, true>(lds, gm, S, E, wave_s);
#endif
        }
        xcd_barrier(xbar, wave_s == 0 && lane_id_opaque() == 0);
#ifndef NO_MIXER
        for (int tile = vcu; tile < T_TOK / 128; tile += G) mixer_unit(p, lds, tile, layer, wave_s);
#endif
        xcd_barrier(xbar, wave_s == 0 && lane_id_opaque() == 0);
        {
            pg8::Gemm gm{P, (const bf16_t*)(ws + WS_WOUT) + (size_t)layer * 2048 * 2048, T_TOK, DM, DM, PW};
            pg8::StaticOrder S; S.init(T_TOK, DM, G, bx);
            pg8::EpiOut E;
            E.x0a = p.x_prompt; E.x0b = p.x_sample; E.mode = layer; E.XN = XN; E.rowtab = RA; E.SSn = layer == 0 ? SS1 : SSF;
#ifndef NO_G3
            pg8::gemm_phase<pg8::EpiOut, pg8::StaticOrder, true>(lds, gm, S, E, wave_s);
#endif
        }
        xcd_barrier(xbar, wave_s == 0 && lane_id_opaque() == 0);
    }
    {
        int tidf = wave_s * 64 + lane_id_opaque(); asm volatile("" : "+v"(tidf));
        const int tid = tidf, lane = tid & 63, wave = tid >> 6;
        const int gw = vcu * 8 + wave, NGW = G * 8;
        f32x4 gf[4][2];
#pragma unroll
        for (int j = 0; j < 4; ++j) { gf[j][0] = ((const GAS f32x4*)p.final_norm)[2 * (lane + 64 * j)]; gf[j][1] = ((const GAS f32x4*)p.final_norm)[2 * (lane + 64 * j) + 1]; }
        for (int row = gw; row < T_TOK; row += NGW) {
            const GAS u32x4* yr = (const GAS u32x4*)((const GAS bf16_t*)(ws + WS_XN) + (size_t)row * 2048);
            GAS f32x4* orow = (GAS f32x4*)((GAS float*)p.out + (size_t)row * 2048);
            const float rs = rsqrtf(((const GAS float*)SSF)[row] * (1.0f / 2048.0f) + EPS);
#pragma unroll
            for (int j = 0; j < 4; ++j) {
                const u32x4 w = yr[lane + 64 * j];
                orow[2 * (lane + 64 * j)] = (f32x4){bf_lo(w.x), bf_hi(w.x), bf_lo(w.y), bf_hi(w.y)} * rs * gf[j][0];
                orow[2 * (lane + 64 * j) + 1] = (f32x4){bf_lo(w.z), bf_hi(w.z), bf_lo(w.w), bf_hi(w.w)} * rs * gf[j][1];
            }
        }
    }
}

extern "C" void kernel_launch(void* const* d_in, const int* in_sizes, int n_in, void* d_out, int out_size, void* d_ws, size_t ws_size, hipStream_t stream) {
    static int grid = 0;
    if (grid == 0) {
        int dev = 0, cus = 0, per_cu = 0;
        hipGetDevice(&dev);
        hipDeviceGetAttribute(&cus, hipDeviceAttributeMultiprocessorCount, dev);
        hipFuncSetAttribute((const void*)hymba_fwd, hipFuncAttributeMaxDynamicSharedMemorySize, LDS_BYTES);
        hipOccupancyMaxActiveBlocksPerMultiprocessor(&per_cu, (const void*)hymba_fwd, NTHREADS, LDS_BYTES);
        if (per_cu < 1) { fprintf(stderr, "kernel_launch: occupancy query says %d blocks/CU\n", per_cu); per_cu = 1; }
        grid = cus;
        if (ws_size < WS_END) fprintf(stderr, "kernel_launch: workspace too small: %zu < %zu\n", ws_size, (size_t)WS_END);
        (void)hipGetLastError();
    }
    Params p{};
    p.x_prompt = (const float*)d_in[0]; p.x_sample = (const float*)d_in[1]; p.mem_prompt = (const float*)d_in[2]; p.mem_sample = (const float*)d_in[3];
    p.norm_in = (const float*)d_in[4]; p.w_in = (const float*)d_in[5]; p.sink = (const float*)d_in[6]; p.conv_w = (const float*)d_in[7];
    p.norm_mem = (const float*)d_in[8]; p.w_mem_kv = (const float*)d_in[9]; p.g_attn = (const float*)d_in[10]; p.g_conv = (const float*)d_in[11];
    p.g_mem = (const float*)d_in[12]; p.w_out = (const float*)d_in[13]; p.final_norm = (const float*)d_in[14];
    p.out = (float*)d_out; p.ws = (unsigned char*)d_ws;
    (void)hipMemsetAsync((unsigned char*)d_ws + WS_CTL, 0, CTL_BYTES, stream);
    void* args[] = {&p};
    hipError_t e = hipLaunchCooperativeKernel((const void*)hymba_fwd, dim3(grid), dim3(NTHREADS), args, LDS_BYTES, stream);
    if (e != hipSuccess) fprintf(stderr, "cooperative launch failed: %s (grid %d)\n", hipGetErrorString(e), grid);
}
```
